# Optimizing an MI355X kernel written in HIP

```python
import math
import jax, jax.numpy as jnp
from jax import lax
import numpy as np

D_MODEL = 2048
BATCH = 4
SEQ = 2048
DEPTH = 1

MIX_WIDTH = D_MODEL
DN_WIDTH = MIX_WIDTH // 2
DN_HEAD_DIM = 128
DN_HEADS = DN_WIDTH // DN_HEAD_DIM
POOL_WIDTH = MIX_WIDTH - DN_WIDTH
POOL_WINDOWS = (2, 4, 8, 16)
POOL_GROUPS = len(POOL_WINDOWS)
POOL_GROUP_DIM = POOL_WIDTH // POOL_GROUPS
SHORT_CONV = 4
CHUNK = 64
D_FF = 5632
FFN_CONV = 3
EPS = 1e-6
IN_WIDTH = 4 * DN_WIDTH + 2 * DN_HEADS + POOL_WIDTH

kernel_name = "hybrid_gdn_pool_convffn"


def rms_norm(x, w):
    xf = x.astype(jnp.float32)
    y = xf * lax.rsqrt(jnp.mean(xf * xf, axis=-1, keepdims=True) + EPS)
    return (y * w.astype(jnp.float32)).astype(x.dtype)


def l2norm(x):
    return x * lax.rsqrt(jnp.sum(x * x, axis=-1, keepdims=True) + EPS)


def causal_dwconv(x, w, b=None):
    K = w.shape[0]
    S = x.shape[1]
    xp = jnp.pad(x, ((0, 0), (K - 1, 0), (0, 0)))
    y = w[0] * xp[:, :S]
    for j in range(1, K):
        y = y + w[j] * xp[:, j:j + S]
    if b is not None:
        y = y + b
    return y


def chunk_gated_delta_rule(q, k, v, beta, g):
    B, H, S, dk = q.shape
    dv = v.shape[-1]
    n = S // CHUNK
    q = q * (dk ** -0.5)
    rs = lambda t: t.reshape(B, H, n, CHUNK, *t.shape[3:])
    q, k, v, beta, g = rs(q), rs(k), rs(v), rs(beta), rs(g)
    g = jnp.cumsum(g, axis=-1)
    k_beta = k * beta[..., None]
    v_beta = v * beta[..., None]
    idx = jnp.arange(CHUNK)
    causal = idx[:, None] >= idx[None, :]
    strict = idx[:, None] > idx[None, :]
    decay = jnp.exp(jnp.where(causal, g[..., :, None] - g[..., None, :], -jnp.inf))
    L = jnp.where(strict, jnp.einsum('bhncd,bhnmd->bhncm', k_beta, k) * decay, 0.0)
    eye = jnp.eye(CHUNK, dtype=q.dtype)
    rhs = jnp.concatenate([v_beta, k_beta * jnp.exp(g)[..., None]], axis=-1)
    sol = lax.linalg.triangular_solve(L + eye, rhs, left_side=True, lower=True, unit_diagonal=True)
    value, k_cum = sol[..., :dv], sol[..., dv:]
    qk = jnp.einsum('bhncd,bhnmd->bhncm', q, k) * decay
    q_g = q * jnp.exp(g)[..., None]
    k_tail = k * jnp.exp(g[..., -1:] - g)[..., None]
    g_last = jnp.exp(g[..., -1])
    xs = tuple(jnp.moveaxis(t, 2, 0) for t in (qk, q_g, k_tail, value, k_cum, g_last))

    def step(state, inp):
        qk_c, qg_c, kt_c, v_c, kc_c, gl_c = inp
        v_new = v_c - jnp.einsum('bhcd,bhde->bhce', kc_c, state)
        o = jnp.einsum('bhcd,bhde->bhce', qg_c, state) + jnp.einsum('bhcm,bhme->bhce', qk_c, v_new)
        state = state * gl_c[..., None, None] + jnp.einsum('bhcd,bhce->bhde', kt_c, v_new)
        return state, o

    state0 = jnp.zeros((B, H, dk, dv), dtype=q.dtype)
    _, o = lax.scan(step, state0, xs)
    return jnp.moveaxis(o, 0, 2).reshape(B, H, S, dv)


def multiscale_pool(u, pool_w, pool_scale):
    B, S, _ = u.shape
    uf = u.astype(jnp.float32).reshape(B, S, POOL_GROUPS, POOL_GROUP_DIM)
    csum = jnp.cumsum(uf, axis=1)
    pos = jnp.arange(1, S + 1, dtype=jnp.float32)[None, :, None]
    pooled = []
    for gi, w in enumerate(POOL_WINDOWS):
        c = csum[:, :, gi]
        prev = jnp.pad(c, ((0, 0), (w, 0), (0, 0)))[:, :S]
        pooled.append((c - prev) / jnp.minimum(pos, float(w)) - uf[:, :, gi])
    d = jnp.stack(pooled, axis=2)
    y = jnp.einsum('bsgc,gcd->bsgd', d, pool_w.astype(jnp.float32)).reshape(B, S, POOL_WIDTH)
    return (y * pool_scale.astype(jnp.float32)).astype(u.dtype)


def hybrid_layer(x, norm1_w, w_in, conv_qkv_w, a_log, dt_bias, out_norm_w, pool_w, pool_scale,
                 w_out, norm2_w, w_up, conv_ffn_w, conv_ffn_b, w_down):
    B, S, _ = x.shape
    f32 = jnp.float32
    h = rms_norm(x, norm1_w)
    proj = h @ w_in
    cuts = [3 * DN_WIDTH, 4 * DN_WIDTH, 4 * DN_WIDTH + DN_HEADS, 4 * DN_WIDTH + 2 * DN_HEADS]
    qkv, z, beta_logit, a_logit, u = jnp.split(proj, cuts, axis=-1)
    qkv = jax.nn.silu(causal_dwconv(qkv, conv_qkv_w))
    q, k, v = jnp.split(qkv, 3, axis=-1)
    to_heads = lambda t: t.reshape(B, S, DN_HEADS, DN_HEAD_DIM).transpose(0, 2, 1, 3).astype(f32)
    q = l2norm(to_heads(q))
    k = l2norm(to_heads(k))
    v = to_heads(v)
    beta = jax.nn.sigmoid(beta_logit.astype(f32)).transpose(0, 2, 1)
    g = (-jnp.exp(a_log.astype(f32)) *
         jax.nn.softplus(a_logit.astype(f32) + dt_bias.astype(f32))).transpose(0, 2, 1)
    o = chunk_gated_delta_rule(q, k, v, beta, g).transpose(0, 2, 1, 3)
    o = rms_norm(o, out_norm_w) * jax.nn.silu(z.reshape(B, S, DN_HEADS, DN_HEAD_DIM).astype(f32))
    o_dn = o.reshape(B, S, DN_WIDTH).astype(x.dtype)
    o_pool = multiscale_pool(u, pool_w, pool_scale)
    x = x + jnp.concatenate([o_dn, o_pool], axis=-1) @ w_out
    h = rms_norm(x, norm2_w)
    up = causal_dwconv(h @ w_up, conv_ffn_w, conv_ffn_b)
    gate, val = jnp.split(up, 2, axis=-1)
    x = x + (jax.nn.silu(gate) * val) @ w_down
    return x


def setup_inputs(seed: int = 0) -> dict:
    key = jax.random.key(seed)
    ks = jax.random.split(key, 17)
    nrm = lambda k, shape, s: jax.random.normal(k, shape, dtype=jnp.float32) * s
    L = DEPTH
    dt = jnp.exp(jax.random.uniform(ks[5], (L, DN_HEADS), minval=math.log(1e-3), maxval=math.log(0.1)))
    return {
        "x": nrm(ks[0], (BATCH, SEQ, D_MODEL), 1.0),
        "norm1_w": 1.0 + nrm(ks[1], (L, D_MODEL), 0.02),
        "w_in": nrm(ks[2], (L, D_MODEL, IN_WIDTH), D_MODEL ** -0.5),
        "conv_qkv_w": nrm(ks[3], (L, SHORT_CONV, 3 * DN_WIDTH), SHORT_CONV ** -0.5),
        "a_log": jnp.log(jax.random.uniform(ks[4], (L, DN_HEADS), minval=1.0, maxval=16.0)),
        "dt_bias": dt + jnp.log(-jnp.expm1(-dt)),
        "out_norm_w": 1.0 + nrm(ks[6], (L, DN_HEAD_DIM), 0.02),
        "pool_w": nrm(ks[7], (L, POOL_GROUPS, POOL_GROUP_DIM, POOL_GROUP_DIM), POOL_GROUP_DIM ** -0.5),
        "pool_scale": 1.0 + nrm(ks[8], (L, POOL_WIDTH), 0.02),
        "w_out": nrm(ks[9], (L, MIX_WIDTH, D_MODEL), MIX_WIDTH ** -0.5),
        "norm2_w": 1.0 + nrm(ks[10], (L, D_MODEL), 0.02),
        "w_up": nrm(ks[11], (L, D_MODEL, 2 * D_FF), D_MODEL ** -0.5),
        "conv_ffn_w": nrm(ks[12], (L, FFN_CONV, 2 * D_FF), FFN_CONV ** -0.5),
        "conv_ffn_b": nrm(ks[13], (L, 2 * D_FF), 0.01),
        "w_down": nrm(ks[14], (L, D_FF, D_MODEL), D_FF ** -0.5),
        "final_norm_w": 1.0 + nrm(ks[15], (D_MODEL,), 0.02),
    }


def reference(x, norm1_w, w_in, conv_qkv_w, a_log, dt_bias, out_norm_w, pool_w, pool_scale,
              w_out, norm2_w, w_up, conv_ffn_w, conv_ffn_b, w_down, final_norm_w):
    for l in range(DEPTH):
        x = hybrid_layer(x, norm1_w[l], w_in[l], conv_qkv_w[l], a_log[l], dt_bias[l], out_norm_w[l],
                         pool_w[l], pool_scale[l], w_out[l], norm2_w[l], w_up[l], conv_ffn_w[l],
                         conv_ffn_b[l], w_down[l])
    return rms_norm(x, final_norm_w)
```

```cpp
#include <hip/hip_runtime.h>
#include <hip/hip_cooperative_groups.h>
#include <cstdio>
#include <cstdint>
namespace cg = cooperative_groups;

#ifndef ONE_LAUNCH
#define ONE_LAUNCH 1
#endif

#define LAS __attribute__((address_space(3)))
typedef unsigned short bf16_t;
typedef short bf16x8 __attribute__((ext_vector_type(8)));
typedef float f32x4 __attribute__((ext_vector_type(4)));
typedef float f32x2 __attribute__((ext_vector_type(2)));
typedef float f32x16 __attribute__((ext_vector_type(16)));
typedef unsigned u32x4 __attribute__((ext_vector_type(4)));
typedef unsigned u32x2 __attribute__((ext_vector_type(2)));
typedef __bf16 bf16x2_t __attribute__((ext_vector_type(2)));

__device__ __forceinline__ unsigned pk2(float lo, float hi) { f32x2 v = {lo, hi}; bf16x2_t r = __builtin_convertvector(v, bf16x2_t); return __builtin_bit_cast(unsigned, r); }
__device__ __forceinline__ float bflo(unsigned w) { return __uint_as_float(w << 16); }
__device__ __forceinline__ float bfhi(unsigned w) { return __uint_as_float(w & 0xffff0000u); }
__device__ __forceinline__ float silu_f(float x) { return x / (1.0f + __expf(-x)); }

constexpr int SEQ = 2048, DM = 2048, MTOK = 8192;
constexpr int NH = 8, HD = 128, CH = 64, NCH = SEQ / CH;
constexpr int DFF = 5632, NUP = 2 * DFF;
constexpr int INW = 5136, NPROJ = 5120, N1 = 5376;
constexpr float EPS = 1e-6f;

constexpr size_t OFF_WIN = 0;
constexpr size_t OFF_WOUT = OFF_WIN + (size_t)N1 * DM * 2;
constexpr size_t OFF_WUP = OFF_WOUT + (size_t)DM * DM * 2;
constexpr size_t OFF_XB = OFF_WUP + (size_t)NUP * DM * 2;
constexpr size_t OFF_ACT = 0;
constexpr size_t OFF_WDOWN = OFF_XB + (size_t)MTOK * DM * 2;
constexpr size_t OFF_POOLT = OFF_WDOWN + (size_t)DM * DFF * 2;
constexpr size_t OFF_LOGIT = OFF_POOLT + 4 * 256 * 256 * 2;
constexpr size_t OFF_RSTD1 = OFF_LOGIT + (size_t)MTOK * 16 * 4;
constexpr size_t OFF_SSQ2 = OFF_RSTD1 + MTOK * 4;
constexpr size_t OFF_SSQ3 = OFF_SSQ2 + MTOK * 4;
constexpr size_t OFF_GLAST = OFF_SSQ3 + MTOK * 4;
constexpr size_t OFF_B = ((OFF_GLAST + 4096 + 1048575) / 1048576) * 1048576;
constexpr size_t OFF_UP = OFF_B;
constexpr size_t OFF_PROJ = OFF_B;
constexpr size_t CHUNK_BYTES = 32768 + 16384 * 3 + 8192;
constexpr size_t OFF_CHUNK = OFF_PROJ + (size_t)MTOK * NPROJ * 2;
constexpr size_t OFF_DPOOL = OFF_CHUNK + 1024 * CHUNK_BYTES;
constexpr size_t OFF_MIX = OFF_DPOOL + (size_t)MTOK * 1024 * 2;
constexpr size_t WS_END = OFF_MIX + (size_t)MTOK * DM * 2;
static_assert(OFF_ACT + (size_t)MTOK * DFF * 2 <= OFF_WDOWN, "act overlay");
static_assert(OFF_UP + (size_t)MTOK * NUP * 2 <= WS_END, "up overlay");

constexpr int LDS_BYTES = 147456;

namespace pg8 {
constexpr int BM = 256, BK = 64, HALF = 128, HTB = HALF * BK * 2, NXCD = 8, WGM = 8;
__host__ __device__ __forceinline__ int lds_byte(int r, int c) { const int st = (r >> 4) * 2 + (c >> 5), rr = r & 15, cc = c & 31, ob = rr * 64 + cc * 2; return st * 1024 + (ob ^ (((ob >> 9) & 1) << 5)); }
__host__ __device__ __forceinline__ void stage_rc(int b, int& R, int& C) { const int st = b / 1024, sb = b % 1024, swz = sb ^ (((sb >> 9) & 1) << 5); R = (st >> 1) * 16 + swz / 64; C = (st & 1) * 32 + (swz % 64) / 2; }
__host__ __device__ __forceinline__ int perm32(int rho) { const int n = rho >> 4, i = rho & 15; return 8 * (i >> 2) + 4 * n + (i & 3); }

struct Unit { int pm, pn; };
struct Gemm { const bf16_t* A; const bf16_t* Bt; int M, N, K, lda, ldb, a_pn_off; };

struct StaticOrder {
    int nM, nN, nwg, G, c;
    __host__ __device__ void init(int M, int N, int G_, int c_) { nM = M / BM; nN = N / BM; nwg = nM * nN; G = G_; c = c_; }
    __host__ __device__ bool next(int i, Unit& u) const {
        if (c < 0) return false;
        const long L = (long)i * G + c; if (L >= nwg) return false;
        int wgid = (int)L; { const int q = nwg / NXCD, r = nwg % NXCD, xcd = wgid % NXCD, off = wgid / NXCD; wgid = (xcd < r ? xcd * (q + 1) : r * (q + 1) + (xcd - r) * q) + off; }
        const int nig = WGM * nN, gid = wgid / nig, fm = gid * WGM, gsz = (nM - fm) < WGM ? (nM - fm) : WGM;
        u.pm = fm + ((wgid % nig) % gsz); u.pn = (wgid % nig) / gsz; return true;
    }
};

template <class Epi>
__device__ __forceinline__ void gemm_phase(LAS unsigned char* lds, const Gemm g, const StaticOrder& S, const Epi& E) {
    const int tid = threadIdx.x, wid = __builtin_amdgcn_readfirstlane(tid >> 6), lane = tid & 63, wr = wid >> 2, wc = wid & 3, fr = lane & 15, fq = lane >> 4;
    const int K = g.K, nt = K / BK;
    unsigned voffA[2], voffB[2];
#pragma unroll
    for (int i = 0; i < 2; ++i) { int R, C; stage_rc(tid * 16 + i * 8192, R, C); const int Rb = Epi::PERM ? ((R & ~31) + perm32(R & 31)) : R;
        voffA[i] = (unsigned)(R * g.lda + C) * 2u; voffB[i] = (unsigned)(Rb * g.ldb + C) * 2u; }
    const size_t kstep = (size_t)(BK * 2);
    const size_t hstepA = (size_t)HALF * g.lda * 2, hstepB = (size_t)HALF * g.ldb * 2;
    const size_t tstepA = 2 * hstepA, tstepB = 2 * hstepB;
    const unsigned ldsw = (unsigned)wid * 1024u;
    const int aoff = lds_byte(wr * 64 + fr, fq * 8), boff = lds_byte(wc * 32 + fr, fq * 8);
#define PG8_SA(b, h) (((b) * 2 + (h)) * HTB)
#define PG8_SB(b, h) ((4 + (b) * 2 + (h)) * HTB)
#define PG8_STAGE(bufoff, gbase, voff) do { _Pragma("unroll") for (int _i = 0; _i < 2; ++_i) \
        __builtin_amdgcn_global_load_lds((const unsigned*)((const char*)(gbase) + (voff)[_i]), (LAS unsigned*)(lds + (bufoff) + ldsw + _i * 8192), 16, 0, 0); } while (0)
#define PG8_LDA(dst, b, h) do { _Pragma("unroll") for (int m = 0; m < 4; ++m) _Pragma("unroll") for (int k = 0; k < 2; ++k) dst[m][k] = *(const LAS bf16x8*)(lds + PG8_SA(b, h) + aoff + m * 2048 + k * 1024); } while (0)
#define PG8_LDB(dst, b, h) do { _Pragma("unroll") for (int n = 0; n < 2; ++n) _Pragma("unroll") for (int k = 0; k < 2; ++k) dst[n][k] = *(const LAS bf16x8*)(lds + PG8_SB(b, h) + boff + n * 2048 + k * 1024); } while (0)
#define PG8_MMA(ai, bj, At, Bt) do { __builtin_amdgcn_s_setprio(1); _Pragma("unroll") for (int m = 0; m < 4; ++m) _Pragma("unroll") for (int n = 0; n < 2; ++n) _Pragma("unroll") for (int k = 0; k < 2; ++k) \
        acc[ai][bj][m][n] = __builtin_amdgcn_mfma_f32_16x16x32_bf16(Bt[n][k], At[m][k], acc[ai][bj][m][n], 0, 0, 0); __builtin_amdgcn_s_setprio(0); } while (0)
#define PG8_WAIT_V(n) asm volatile("s_waitcnt vmcnt(" #n ")" ::: "memory")
#define PG8_WAIT_L(n) asm volatile("s_waitcnt lgkmcnt(" #n ")" ::: "memory")
#define PG8_BAR __builtin_amdgcn_s_barrier()
#define PG8_SCHED __builtin_amdgcn_sched_barrier(0)
    Unit cur, nxt; int ui = 0;
    if (!S.next(0, cur)) return;
    f32x4 acc[2][2][4][2];
#pragma unroll
    for (int a = 0; a < 2; ++a)
#pragma unroll
        for (int b = 0; b < 2; ++b)
#pragma unroll
            for (int m = 0; m < 4; ++m)
#pragma unroll
                for (int n = 0; n < 2; ++n) acc[a][b][m][n] = (f32x4){0.f, 0.f, 0.f, 0.f};
    bf16x8 At[4][2], B0[2][2], B1[2][2];
    const char* cA = (const char*)g.A + (size_t)cur.pm * tstepA + (size_t)cur.pn * g.a_pn_off; const char* cB = (const char*)g.Bt + (size_t)cur.pn * tstepB;
    PG8_STAGE(PG8_SB(0, 0), cB, voffB); PG8_STAGE(PG8_SB(0, 1), cB + hstepB, voffB); PG8_STAGE(PG8_SA(0, 0), cA, voffA); PG8_STAGE(PG8_SA(0, 1), cA + hstepA, voffA);
    if (wr == 1) PG8_BAR;
    PG8_WAIT_V(2); PG8_BAR;
    PG8_STAGE(PG8_SB(1, 0), cB + kstep, voffB); PG8_STAGE(PG8_SA(1, 0), cA + kstep, voffA); PG8_STAGE(PG8_SB(1, 1), cB + hstepB + kstep, voffB);
    PG8_WAIT_V(6); PG8_BAR;
    for (;;) {
        const bool has_next = S.next(ui + 1, nxt);
        const char* nA = has_next ? (const char*)g.A + (size_t)nxt.pm * tstepA + (size_t)nxt.pn * g.a_pn_off : cA; const char* nB = has_next ? (const char*)g.Bt + (size_t)nxt.pn * tstepB : cB;
        for (int t = 0; t < nt; t += 2) {
            const bool last = (t == nt - 2);
            const char* a1 = cA + (size_t)(t + 1) * kstep;
            const char* a2 = last ? nA : cA + (size_t)(t + 2) * kstep; const char* b2 = last ? nB : cB + (size_t)(t + 2) * kstep;
            const char* a3 = a2 + kstep; const char* b3 = b2 + kstep;
            PG8_LDB(B0, 0, 0); PG8_LDB(B1, 0, 1); PG8_SCHED; PG8_LDA(At, 0, 0); PG8_STAGE(PG8_SA(1, 1), a1 + hstepA, voffA);
            PG8_WAIT_V(8); PG8_WAIT_L(0); PG8_BAR; PG8_MMA(0, 0, At, B0); PG8_MMA(0, 1, At, B1); PG8_BAR; PG8_SCHED;
            PG8_LDA(At, 0, 1); PG8_STAGE(PG8_SB(0, 0), b2, voffB); PG8_STAGE(PG8_SB(0, 1), b2 + hstepB, voffB); PG8_STAGE(PG8_SA(0, 0), a2, voffA);
            PG8_WAIT_V(8); PG8_WAIT_L(0); PG8_BAR; PG8_MMA(1, 0, At, B0); PG8_MMA(1, 1, At, B1); PG8_BAR; PG8_SCHED;
            PG8_LDB(B0, 1, 0); PG8_LDB(B1, 1, 1); PG8_SCHED; PG8_LDA(At, 1, 0); PG8_STAGE(PG8_SA(0, 1), a2 + hstepA, voffA);
            PG8_WAIT_V(8); PG8_WAIT_L(0); PG8_BAR; PG8_MMA(0, 0, At, B0); PG8_MMA(0, 1, At, B1); PG8_BAR; PG8_SCHED;
            PG8_LDA(At, 1, 1); PG8_STAGE(PG8_SB(1, 0), b3, voffB); PG8_STAGE(PG8_SB(1, 1), b3 + hstepB, voffB); PG8_STAGE(PG8_SA(1, 0), a3, voffA);
            PG8_WAIT_V(8); PG8_WAIT_L(0); PG8_BAR; PG8_MMA(1, 0, At, B0); PG8_MMA(1, 1, At, B1); PG8_BAR; PG8_SCHED;
        }
        if (wr == 0) PG8_BAR;
        E(acc, cur, wr, wc, fr, fq);
        if (!has_next) break;
#pragma unroll
        for (int a = 0; a < 2; ++a)
#pragma unroll
            for (int b = 0; b < 2; ++b)
#pragma unroll
                for (int m = 0; m < 4; ++m)
#pragma unroll
                    for (int n = 0; n < 2; ++n) acc[a][b][m][n] = (f32x4){0.f, 0.f, 0.f, 0.f};
        cur = nxt; cA = nA; cB = nB; ++ui;
        if (wr == 1) PG8_BAR;
    }
    PG8_WAIT_V(0);
    PG8_BAR;
#undef PG8_SA
#undef PG8_SB
#undef PG8_STAGE
#undef PG8_LDA
#undef PG8_LDB
#undef PG8_MMA
#undef PG8_WAIT_V
#undef PG8_WAIT_L
#undef PG8_BAR
#undef PG8_SCHED
}
}

struct EpiProj {
    static constexpr bool PERM = true;
    bf16_t* P; float* logits; const float* rstd;
    __device__ __forceinline__ void operator()(const f32x4 (&acc)[2][2][4][2], const pg8::Unit& u, int wr, int wc, int fr, int fq) const {
        const int row0 = u.pm * 256 + wr * 64 + fr;
        if (u.pn < 20) {
            const int col0 = u.pn * 256 + wc * 32 + 8 * fq;
#pragma unroll
            for (int ai = 0; ai < 2; ++ai)
#pragma unroll
                for (int m = 0; m < 4; ++m) { const int row = row0 + ai * 128 + m * 16; const float rs = rstd[row]; bf16_t* rowp = P + (size_t)row * NPROJ + col0;
#pragma unroll
                    for (int bj = 0; bj < 2; ++bj) { const f32x4 v0 = acc[ai][bj][m][0] * rs, v1 = acc[ai][bj][m][1] * rs;
                        u32x4 w; w.x = pk2(v0[0], v0[1]); w.y = pk2(v0[2], v0[3]); w.z = pk2(v1[0], v1[1]); w.w = pk2(v1[2], v1[3]);
                        *(u32x4*)(rowp + bj * 128) = w; } }
        } else if (wc == 0 && fq < 2) {
#pragma unroll
            for (int ai = 0; ai < 2; ++ai)
#pragma unroll
                for (int m = 0; m < 4; ++m) { const int row = row0 + ai * 128 + m * 16; const float rs = rstd[row]; float* lp = logits + (size_t)row * 16 + 8 * fq;
                    *(f32x4*)lp = acc[ai][0][m][0] * rs; *(f32x4*)(lp + 4) = acc[ai][0][m][1] * rs; }
        }
    }
};
struct EpiBf {
    static constexpr bool PERM = true;
    bf16_t* O; int ldc; int colbase; const float* ssq;
    __device__ __forceinline__ void operator()(const f32x4 (&acc)[2][2][4][2], const pg8::Unit& u, int wr, int wc, int fr, int fq) const {
        const int row0 = u.pm * 256 + wr * 64 + fr; const int col0 = colbase + u.pn * 256 + wc * 32 + 8 * fq;
#pragma unroll
        for (int ai = 0; ai < 2; ++ai)
#pragma unroll
            for (int m = 0; m < 4; ++m) { const int row = row0 + ai * 128 + m * 16; const float rs = ssq ? rsqrtf(ssq[row] * (1.0f / DM) + EPS) : 1.0f; bf16_t* rowp = O + (size_t)row * ldc + col0;
#pragma unroll
                for (int bj = 0; bj < 2; ++bj) { const f32x4 v0 = acc[ai][bj][m][0] * rs, v1 = acc[ai][bj][m][1] * rs;
                    u32x4 w; w.x = pk2(v0[0], v0[1]); w.y = pk2(v0[2], v0[3]); w.z = pk2(v1[0], v1[1]); w.w = pk2(v1[2], v1[3]);
                    *(u32x4*)(rowp + bj * 128) = w; } }
    }
};
struct EpiRes {
    static constexpr bool PERM = false;
    const float* base; float* out; bf16_t* ob; float* ssq;
    __device__ __forceinline__ void operator()(const f32x4 (&acc)[2][2][4][2], const pg8::Unit& u, int wr, int wc, int fr, int fq) const {
        const int row0 = u.pm * 256 + wr * 64 + fr, col0 = u.pn * 256 + wc * 32 + 4 * fq;
#pragma unroll
        for (int ai = 0; ai < 2; ++ai)
#pragma unroll
            for (int m = 0; m < 4; ++m) { const int row = row0 + ai * 128 + m * 16; const size_t off = (size_t)row * DM + col0; float ss = 0.f;
#pragma unroll
                for (int bj = 0; bj < 2; ++bj)
#pragma unroll
                    for (int n = 0; n < 2; ++n) { const f32x4 b = *(const f32x4*)(base + off + bj * 128 + n * 16); const f32x4 v = b + acc[ai][bj][m][n];
                        *(f32x4*)(out + off + bj * 128 + n * 16) = v; ss += (v[0] * v[0] + v[1] * v[1]) + (v[2] * v[2] + v[3] * v[3]);
                        if (ob) { u32x2 w; w.x = pk2(v[0], v[1]); w.y = pk2(v[2], v[3]); *(u32x2*)(ob + off + bj * 128 + n * 16) = w; } }
                ss += __shfl_xor(ss, 16); ss += __shfl_xor(ss, 32);
                if (fq == 0) atomicAdd(ssq + row, ss);
                asm volatile("" ::: "memory"); }
    }
};

struct Params { const float* in[16]; float* out; unsigned char* ws; int ph_lo, ph_hi; };
enum { I_X = 0, I_N1W, I_WIN, I_CONVQ, I_ALOG, I_DTB, I_ONW, I_POOLW, I_POOLS, I_WOUT, I_N2W, I_WUP, I_CONVF, I_CONVFB, I_WDOWN, I_FNW };

__device__ __forceinline__ void tr_item(const float* W, int ldw, int col0, int nvalid, bf16_t* WT, int ldk, int row0, int k0, const float* kscale, const float* nscale, LAS float* scr, int lane) {
    const int n = lane & 31;
#pragma unroll 8
    for (int i = 0; i < 32; ++i) { const int kk = 2 * i + (lane >> 5); float v = (n < nvalid) ? W[(size_t)(k0 + kk) * ldw + col0 + n] : 0.f; if (kscale) v *= kscale[k0 + kk]; scr[kk * 33 + n] = v; }
    asm volatile("s_waitcnt lgkmcnt(0)" ::: "memory");
    const int c = lane & 7;
#pragma unroll
    for (int j = 0; j < 4; ++j) { const int nn = (lane >> 3) + 8 * j; const LAS float* s = scr + (8 * c) * 33 + nn; const float sc = nscale ? nscale[nn] : 1.0f;
        u32x4 o; o.x = pk2(s[0 * 33] * sc, s[1 * 33] * sc); o.y = pk2(s[2 * 33] * sc, s[3 * 33] * sc); o.z = pk2(s[4 * 33] * sc, s[5 * 33] * sc); o.w = pk2(s[6 * 33] * sc, s[7 * 33] * sc);
        *(u32x4*)(WT + (size_t)(row0 + nn) * ldk + k0 + 8 * c) = o; }
    asm volatile("s_waitcnt lgkmcnt(0)" ::: "memory");
}
__device__ __forceinline__ float wave_sum(float v) {
#pragma unroll
    for (int o = 1; o < 64; o <<= 1) v += __shfl_xor(v, o);
    return v;
}
__device__ __forceinline__ void phase_prep(const Params& p, LAS unsigned char* lds) {
    const int tid = threadIdx.x, lane = tid & 63, wave = tid >> 6;
    const int gw = blockIdx.x * 8 + wave, NGW = gridDim.x * 8;
    unsigned char* ws = p.ws;
    LAS float* scr = (LAS float*)(lds + wave * 16384);
    bf16_t* WinT = (bf16_t*)(ws + OFF_WIN); bf16_t* WoutT = (bf16_t*)(ws + OFF_WOUT); bf16_t* WupT = (bf16_t*)(ws + OFF_WUP); bf16_t* WdownT = (bf16_t*)(ws + OFF_WDOWN); bf16_t* PoolT = (bf16_t*)(ws + OFF_POOLT);
    constexpr int I_A = 32 * 128, I_B = 32 * 32, I_C = 32, I_O = 32 * 64, I_U = 32 * 352, I_D = 88 * 64, I_P = 128;
    constexpr int NIT = I_A + I_B + I_C + I_O + I_U + I_D + I_P;
    for (int it = gw; it < NIT; it += NGW) {
        int r = it;
        if (r < I_A) { const int kb = r / 128, nb = r % 128; tr_item(p.in[I_WIN], INW, 32 * nb, 32, WinT, DM, 32 * nb, 64 * kb, p.in[I_N1W], nullptr, scr, lane); continue; } r -= I_A;
        if (r < I_B) { const int kb = r / 32, nb = r % 32; tr_item(p.in[I_WIN], INW, 4112 + 32 * nb, 32, WinT, DM, 4096 + 32 * nb, 64 * kb, p.in[I_N1W], nullptr, scr, lane); continue; } r -= I_B;
        if (r < I_C) { tr_item(p.in[I_WIN], INW, 4096, 16, WinT, DM, 5120, 64 * r, p.in[I_N1W], nullptr, scr, lane); continue; } r -= I_C;
        if (r < I_O) { const int kb = r / 64, nb = r % 64; tr_item(p.in[I_WOUT], DM, 32 * nb, 32, WoutT, DM, 32 * nb, 64 * kb, nullptr, nullptr, scr, lane); continue; } r -= I_O;
        if (r < I_U) { const int kb = r / 352, nb = r % 352; tr_item(p.in[I_WUP], NUP, 32 * nb, 32, WupT, DM, 32 * nb, 64 * kb, p.in[I_N2W], nullptr, scr, lane); continue; } r -= I_U;
        if (r < I_D) { const int kb = r / 64, nb = r % 64; tr_item(p.in[I_WDOWN], DM, 32 * nb, 32, WdownT, DFF, 32 * nb, 64 * kb, nullptr, nullptr, scr, lane); continue; } r -= I_D;
        { const int g = r / 32, kb = (r % 32) / 8, nb = r % 8; tr_item(p.in[I_POOLW] + (size_t)g * 65536, 256, 32 * nb, 32, PoolT + (size_t)g * 65536, 256, 32 * nb, 64 * kb, nullptr, p.in[I_POOLS] + g * 256 + 32 * nb, scr, lane); }
    }
    { u32x4* z = (u32x4*)(WinT + (size_t)5152 * DM); const int nz = (N1 - 5152) * DM / 8;
      for (int i = blockIdx.x * 512 + tid; i < nz; i += gridDim.x * 512) z[i] = (u32x4){0u, 0u, 0u, 0u}; }
    { float* z = (float*)(ws + OFF_SSQ2); for (int i = blockIdx.x * 512 + tid; i < 2 * MTOK; i += gridDim.x * 512) z[i] = 0.f; }
    bf16_t* XB = (bf16_t*)(ws + OFF_XB); float* rstd1 = (float*)(ws + OFF_RSTD1);
    for (int m = gw; m < MTOK; m += NGW) {
        const f32x4* xr = (const f32x4*)(p.in[I_X] + (size_t)m * DM) + lane; f32x4 v[8]; float s = 0.f;
#pragma unroll
        for (int j = 0; j < 8; ++j) { v[j] = xr[64 * j]; s += (v[j][0] * v[j][0] + v[j][1] * v[j][1]) + (v[j][2] * v[j][2] + v[j][3] * v[j][3]); }
        s = wave_sum(s);
        if (lane == 0) rstd1[m] = rsqrtf(s * (1.0f / DM) + EPS);
        u32x2* o = (u32x2*)(XB + (size_t)m * DM) + lane;
#pragma unroll
        for (int j = 0; j < 8; ++j) { u32x2 w; w.x = pk2(v[j][0], v[j][1]); w.y = pk2(v[j][2], v[j][3]); o[64 * j] = w; }
    }
}

constexpr int CP_Q = 0, CP_K = 33792, CP_V = 67584, CP_L = 101376, CP_MISC = 118784;
__device__ __forceinline__ void chunk_prep(const Params& p, LAS unsigned char* lds, int item) {
    const int tid = threadIdx.x, lane = tid & 63, wave = tid >> 6;
    const int b = item >> 8, h = (item >> 5) & 7, n = item & 31;
    const int t0 = b * SEQ + n * CH, tl0 = n * CH;
    unsigned char* ws = p.ws;
    const bf16_t* proj = (const bf16_t*)(ws + OFF_PROJ);
    const float* logits = (const float*)(ws + OFF_LOGIT);
    unsigned char* cb = ws + OFF_CHUNK + (size_t)item * CHUNK_BYTES;
    float* value_o = (float*)cb; bf16_t* kcum_o = (bf16_t*)(cb + 32768); bf16_t* qg_o = (bf16_t*)(cb + 49152); bf16_t* ktT_o = (bf16_t*)(cb + 65536); bf16_t* qk_o = (bf16_t*)(cb + 81920);
    LAS float* qS = (LAS float*)(lds + CP_Q); LAS float* kS = (LAS float*)(lds + CP_K); LAS float* vS = (LAS float*)(lds + CP_V); LAS float* Ls = (LAS float*)(lds + CP_L);
    LAS float* betaS = (LAS float*)(lds + CP_MISC); LAS float* gcS = betaS + 64; LAS float* sclk = betaS + 128; LAS float* egS = betaS + 192; LAS float* etS = betaS + 256;
    const float* cw = p.in[I_CONVQ];
    for (int it = tid; it < 3072; it += 512) {
        const int mat = it >> 10, r = (it & 1023) >> 4, c = (it & 15) * 8;
        const int col = mat * 1024 + h * HD + c;
        float a[8];
#pragma unroll
        for (int e = 0; e < 8; ++e) a[e] = 0.f;
#pragma unroll
        for (int j = 0; j < 4; ++j) {
            if (tl0 + r - 3 + j >= 0) {
                const u32x4 raw = *(const u32x4*)(proj + (size_t)(t0 + r - 3 + j) * NPROJ + col);
                const f32x4 w0 = *(const f32x4*)(cw + j * 3072 + col), w1 = *(const f32x4*)(cw + j * 3072 + col + 4);
                a[0] += w0[0] * bflo(raw.x); a[1] += w0[1] * bfhi(raw.x); a[2] += w0[2] * bflo(raw.y); a[3] += w0[3] * bfhi(raw.y);
                a[4] += w1[0] * bflo(raw.z); a[5] += w1[1] * bfhi(raw.z); a[6] += w1[2] * bflo(raw.w); a[7] += w1[3] * bfhi(raw.w);
            }
        }
        LAS float* dst = (mat == 0 ? qS : (mat == 1 ? kS : vS)) + r * 132 + c;
        *(LAS f32x4*)dst = (f32x4){silu_f(a[0]), silu_f(a[1]), silu_f(a[2]), silu_f(a[3])};
        *(LAS f32x4*)(dst + 4) = (f32x4){silu_f(a[4]), silu_f(a[5]), silu_f(a[6]), silu_f(a[7])};
    }
    __syncthreads();
    {
        const int row = tid >> 2, part = tid & 3;
        LAS float* base = (row < 64 ? qS + row * 132 : kS + (row - 64) * 132) + part * 32;
        f32x4 v[8]; float ss = 0.f;
#pragma unroll
        for (int e = 0; e < 8; ++e) { v[e] = *(LAS f32x4*)(base + 4 * e); ss += (v[e][0] * v[e][0] + v[e][1] * v[e][1]) + (v[e][2] * v[e][2] + v[e][3] * v[e][3]); }
        ss += __shfl_xor(ss, 1); ss += __shfl_xor(ss, 2);
        const float sc = rsqrtf(ss + EPS) * (row < 64 ? 0.08838834764831845f : 1.0f);
#pragma unroll
        for (int e = 0; e < 8; ++e) *(LAS f32x4*)(base + 4 * e) = v[e] * sc;
    }
    if (wave == 0) {
        const float lb = logits[(size_t)(t0 + lane) * 16 + h], la = logits[(size_t)(t0 + lane) * 16 + 8 + h];
        const float beta = 1.0f / (1.0f + __expf(-lb));
        const float x = la + p.in[I_DTB][h];
        const float sp = fmaxf(x, 0.f) + log1pf(__expf(-fabsf(x)));
        float g = -__expf(p.in[I_ALOG][h]) * sp;
#pragma unroll
        for (int o = 1; o < 64; o <<= 1) { const float t = __shfl_up(g, o); if (lane >= o) g += t; }
        const float gl = __shfl(g, 63);
        const float eg = __expf(g);
        betaS[lane] = beta; gcS[lane] = g; sclk[lane] = beta * eg; egS[lane] = eg; etS[lane] = __expf(gl - g);
        if (lane == 63) ((float*)(ws + OFF_GLAST))[item] = eg;
    }
    __syncthreads();
    {
        const int half = tid >> 8, t = tid & 255, ty = t >> 4, tx = t & 15;
        const LAS float* A = half ? qS : kS;
        float acc[4][4];
#pragma unroll
        for (int i = 0; i < 4; ++i)
#pragma unroll
            for (int j = 0; j < 4; ++j) acc[i][j] = 0.f;
#pragma unroll 4
        for (int d = 0; d < HD; d += 4) {
            f32x4 av[4], bv[4];
#pragma unroll
            for (int i = 0; i < 4; ++i) { av[i] = *(const LAS f32x4*)(A + (ty + 16 * i) * 132 + d); bv[i] = *(const LAS f32x4*)(kS + (tx + 16 * i) * 132 + d); }
#pragma unroll
            for (int i = 0; i < 4; ++i)
#pragma unroll
                for (int j = 0; j < 4; ++j) acc[i][j] += (av[i][0] * bv[j][0] + av[i][1] * bv[j][1]) + (av[i][2] * bv[j][2] + av[i][3] * bv[j][3]);
        }
#pragma unroll
        for (int i = 0; i < 4; ++i)
#pragma unroll
            for (int j = 0; j < 4; ++j) { const int ii = ty + 16 * i, jj = tx + 16 * j;
                const float dec = (ii >= jj) ? __expf(gcS[ii] - gcS[jj]) : 0.f;
                if (half == 0) Ls[ii * 68 + jj] = (ii > jj) ? betaS[ii] * acc[i][j] * dec : 0.f;
                else { const unsigned w = pk2(acc[i][j] * dec, 0.f); qk_o[ii * 64 + jj] = (bf16_t)(w & 0xffffu); } }
    }
    __syncthreads();
    if (tid < 256) {
        const int c = tid;
        const LAS float* Msrc = (c < 128) ? vS + c : kS + (c - 128);
        const LAS float* scl = (c < 128) ? betaS : sclk;
        float sol[64];
#pragma unroll
        for (int i = 0; i < 64; ++i) {
            float a = Msrc[i * 132] * scl[i];
#pragma unroll
            for (int j4 = 0; j4 < i; j4 += 4) {
                const f32x4 l = *(const LAS f32x4*)(Ls + i * 68 + j4);
                a -= l[0] * sol[j4];
                if (j4 + 1 < i) a -= l[1] * sol[j4 + 1];
                if (j4 + 2 < i) a -= l[2] * sol[j4 + 2];
                if (j4 + 3 < i) a -= l[3] * sol[j4 + 3];
            }
            sol[i] = a;
            if (c < 128) value_o[i * 128 + c] = a;
            else { const unsigned w = pk2(-a, 0.f); kcum_o[i * 128 + (c - 128)] = (bf16_t)(w & 0xffffu); }
        }
    } else {
        const int t = tid - 256;
        for (int it = t; it < 1024; it += 256) { const int i = it >> 4, c = (it & 15) * 8; const float e = egS[i];
            const f32x4 a = *(const LAS f32x4*)(qS + i * 132 + c) * e, bq = *(const LAS f32x4*)(qS + i * 132 + c + 4) * e;
            u32x4 w; w.x = pk2(a[0], a[1]); w.y = pk2(a[2], a[3]); w.z = pk2(bq[0], bq[1]); w.w = pk2(bq[2], bq[3]);
            *(u32x4*)(qg_o + i * 128 + c) = w; }
        for (int it = t; it < 1024; it += 256) { const int d = it & 127, i0 = (it >> 7) * 8; float v[8];
#pragma unroll
            for (int e = 0; e < 8; ++e) v[e] = kS[(i0 + e) * 132 + d] * etS[i0 + e];
            u32x4 w; w.x = pk2(v[0], v[1]); w.y = pk2(v[2], v[3]); w.z = pk2(v[4], v[5]); w.w = pk2(v[6], v[7]);
            *(u32x4*)(ktT_o + d * 64 + i0) = w; }
    }
    __syncthreads();
}
__device__ __forceinline__ void pool_diff(const Params& p) {
    unsigned char* ws = p.ws;
    const bf16_t* proj = (const bf16_t*)(ws + OFF_PROJ); bf16_t* dp = (bf16_t*)(ws + OFF_DPOOL);
    for (int it = blockIdx.x * 512 + threadIdx.x; it < MTOK * 128; it += gridDim.x * 512) {
        const int t = it >> 7, c = (it & 127) * 8, g = c >> 8, w = 2 << g, tl = t & (SEQ - 1);
        const int cnt = (tl + 1 < w) ? tl + 1 : w;
        const bf16_t* src = proj + (size_t)t * NPROJ + 4096 + c;
        float s[8], u0[8];
        { const u32x4 raw = *(const u32x4*)src; u0[0] = bflo(raw.x); u0[1] = bfhi(raw.x); u0[2] = bflo(raw.y); u0[3] = bfhi(raw.y); u0[4] = bflo(raw.z); u0[5] = bfhi(raw.z); u0[6] = bflo(raw.w); u0[7] = bfhi(raw.w); }
#pragma unroll
        for (int e = 0; e < 8; ++e) s[e] = u0[e];
        for (int j = 1; j < cnt; ++j) { const u32x4 raw = *(const u32x4*)(src - (size_t)j * NPROJ);
            s[0] += bflo(raw.x); s[1] += bfhi(raw.x); s[2] += bflo(raw.y); s[3] += bfhi(raw.y); s[4] += bflo(raw.z); s[5] += bfhi(raw.z); s[6] += bflo(raw.w); s[7] += bfhi(raw.w); }
        const float inv = 1.0f / (float)cnt;
        u32x4 o; o.x = pk2(s[0] * inv - u0[0], s[1] * inv - u0[1]); o.y = pk2(s[2] * inv - u0[2], s[3] * inv - u0[3]); o.z = pk2(s[4] * inv - u0[4], s[5] * inv - u0[5]); o.w = pk2(s[6] * inv - u0[6], s[7] * inv - u0[7]);
        *(u32x4*)(dp + (size_t)t * 1024 + c) = o;
    }
}

constexpr int SC_KC = 0, SC_QG = 16896, SC_KT = 33792, SC_QK = 51200, SC_OT = 59904;
__device__ __forceinline__ bf16x8 packh(const f32x16& x, int s) {
    u32x4 r; r.x = pk2(x[8 * s + 0], x[8 * s + 1]); r.y = pk2(x[8 * s + 2], x[8 * s + 3]); r.z = pk2(x[8 * s + 4], x[8 * s + 5]); r.w = pk2(x[8 * s + 6], x[8 * s + 7]);
    return __builtin_bit_cast(bf16x8, r);
}
__device__ __forceinline__ bf16x8 frag_rd(const LAS unsigned char* base, int byteoff) {
    const u32x2 lo = *(const LAS u32x2*)(base + byteoff), hi = *(const LAS u32x2*)(base + byteoff + 16);
    u32x4 r; r.x = lo.x; r.y = lo.y; r.z = hi.x; r.w = hi.y; return __builtin_bit_cast(bf16x8, r);
}
__device__ __forceinline__ void scan_phase(const Params& p, LAS unsigned char* lds, int bh) {
    const int tid = threadIdx.x, lane = tid & 63, wave = __builtin_amdgcn_readfirstlane(tid >> 6);
    const int b = bh >> 3, h = bh & 7;
    unsigned char* ws = p.ws;
    const bf16_t* proj = (const bf16_t*)(ws + OFF_PROJ); bf16_t* mix = (bf16_t*)(ws + OFF_MIX);
    const float* glast = (const float*)(ws + OFF_GLAST);
    const int r = lane & 31, hh = lane >> 5;
    f32x16 S[4]; bf16x8 Sb[8];
#pragma unroll
    for (int i = 0; i < 4; ++i)
#pragma unroll
        for (int e = 0; e < 16; ++e) S[i][e] = 0.f;
#pragma unroll
    for (int i = 0; i < 8; ++i) Sb[i] = (bf16x8){0, 0, 0, 0, 0, 0, 0, 0};
    const int frow = tid >> 3, fpart = tid & 7;
    float onw[16];
#pragma unroll
    for (int e = 0; e < 16; ++e) onw[e] = p.in[I_ONW][16 * fpart + e];
    LAS float* oT = (LAS float*)(lds + SC_OT);
    for (int n = 0; n < NCH; ++n) {
        const int item = bh * 32 + n, t0 = b * SEQ + n * CH;
        const unsigned char* cb = ws + OFF_CHUNK + (size_t)item * CHUNK_BYTES;
        for (int it = tid; it < 3584; it += 512) {
            int q = it; const unsigned char* src; int dst;
            if (q < 1024) { src = cb + 32768 + q * 16; dst = SC_KC + (q >> 4) * 264 + (q & 15) * 16; }
            else if (q < 2048) { q -= 1024; src = cb + 49152 + q * 16; dst = SC_QG + (q >> 4) * 264 + (q & 15) * 16; }
            else if (q < 3072) { q -= 2048; src = cb + 65536 + q * 16; dst = SC_KT + (q >> 3) * 136 + (q & 7) * 16; }
            else { q -= 3072; src = cb + 81920 + q * 16; dst = SC_QK + (q >> 3) * 136 + (q & 7) * 16; }
            const u32x4 v = *(const u32x4*)src;
            *(LAS u32x2*)(lds + dst) = (u32x2){v.x, v.y}; *(LAS u32x2*)(lds + dst + 8) = (u32x2){v.z, v.w};
        }
        f32x16 vn[2];
        if (wave < 4) {
            const float* val = (const float*)cb;
#pragma unroll
            for (int mi = 0; mi < 2; ++mi)
#pragma unroll
                for (int i = 0; i < 16; ++i) vn[mi][i] = val[(32 * mi + (i & 3) + 8 * (i >> 2) + 4 * hh) * 128 + 32 * wave + r];
        }
        __syncthreads();
        if (wave < 4) {
            const float gl = glast[item];
            f32x16 o[2];
#pragma unroll
            for (int mi = 0; mi < 2; ++mi) {
#pragma unroll
                for (int e = 0; e < 16; ++e) o[mi][e] = 0.f;
#pragma unroll
                for (int ks = 0; ks < 8; ++ks) {
                    const int off = (32 * mi + r) * 264 + (16 * ks + 4 * hh) * 2;
                    vn[mi] = __builtin_amdgcn_mfma_f32_32x32x16_bf16(frag_rd(lds + SC_KC, off), Sb[ks], vn[mi], 0, 0, 0);
                    o[mi] = __builtin_amdgcn_mfma_f32_32x32x16_bf16(frag_rd(lds + SC_QG, off), Sb[ks], o[mi], 0, 0, 0);
                }
            }
            bf16x8 vb[4];
#pragma unroll
            for (int ks = 0; ks < 4; ++ks) vb[ks] = packh(vn[ks >> 1], ks & 1);
#pragma unroll
            for (int mi = 0; mi < 2; ++mi)
#pragma unroll
                for (int ks = 0; ks < 4; ++ks)
                    o[mi] = __builtin_amdgcn_mfma_f32_32x32x16_bf16(frag_rd(lds + SC_QK, (32 * mi + r) * 136 + (16 * ks + 4 * hh) * 2), vb[ks], o[mi], 0, 0, 0);
#pragma unroll
            for (int mt = 0; mt < 4; ++mt) {
                S[mt] = S[mt] * gl;
#pragma unroll
                for (int ks = 0; ks < 4; ++ks)
                    S[mt] = __builtin_amdgcn_mfma_f32_32x32x16_bf16(frag_rd(lds + SC_KT, (32 * mt + r) * 136 + (16 * ks + 4 * hh) * 2), vb[ks], S[mt], 0, 0, 0);
                Sb[2 * mt] = packh(S[mt], 0); Sb[2 * mt + 1] = packh(S[mt], 1);
            }
#pragma unroll
            for (int mi = 0; mi < 2; ++mi)
#pragma unroll
                for (int i = 0; i < 16; ++i) oT[(32 * mi + (i & 3) + 8 * (i >> 2) + 4 * hh) * 132 + 32 * wave + r] = o[mi][i];
        }
        __syncthreads();
        {
            f32x4 v[4]; float ss = 0.f;
#pragma unroll
            for (int e = 0; e < 4; ++e) { v[e] = *(const LAS f32x4*)(oT + frow * 132 + 16 * fpart + 4 * e); ss += (v[e][0] * v[e][0] + v[e][1] * v[e][1]) + (v[e][2] * v[e][2] + v[e][3] * v[e][3]); }
            ss += __shfl_xor(ss, 1); ss += __shfl_xor(ss, 2); ss += __shfl_xor(ss, 4);
            const float rs = rsqrtf(ss * (1.0f / HD) + EPS);
            const bf16_t* zp = proj + (size_t)(t0 + frow) * NPROJ + 3072 + h * HD + 16 * fpart;
            const u32x4 z0 = *(const u32x4*)zp, z1 = *(const u32x4*)(zp + 8);
            float zf[16] = {bflo(z0.x), bfhi(z0.x), bflo(z0.y), bfhi(z0.y), bflo(z0.z), bfhi(z0.z), bflo(z0.w), bfhi(z0.w), bflo(z1.x), bfhi(z1.x), bflo(z1.y), bfhi(z1.y), bflo(z1.z), bfhi(z1.z), bflo(z1.w), bfhi(z1.w)};
            float ov[16];
#pragma unroll
            for (int e = 0; e < 16; ++e) ov[e] = v[e >> 2][e & 3] * rs * onw[e] * silu_f(zf[e]);
            u32x4 w0, w1; w0.x = pk2(ov[0], ov[1]); w0.y = pk2(ov[2], ov[3]); w0.z = pk2(ov[4], ov[5]); w0.w = pk2(ov[6], ov[7]);
            w1.x = pk2(ov[8], ov[9]); w1.y = pk2(ov[10], ov[11]); w1.z = pk2(ov[12], ov[13]); w1.w = pk2(ov[14], ov[15]);
            bf16_t* mp = mix + (size_t)(t0 + frow) * DM + h * HD + 16 * fpart;
            *(u32x4*)mp = w0; *(u32x4*)(mp + 8) = w1;
        }
    }
    __syncthreads();
}

__device__ __forceinline__ void act_phase(const Params& p) {
    unsigned char* ws = p.ws;
    const bf16_t* up = (const bf16_t*)(ws + OFF_UP); bf16_t* act = (bf16_t*)(ws + OFF_ACT);
    const float* cw = p.in[I_CONVF]; const float* cbias = p.in[I_CONVFB];
    constexpr int NCG = DFF / 8, RB = 32;
    for (int it = blockIdx.x * 512 + threadIdx.x; it < (MTOK / RB) * NCG; it += gridDim.x * 512) {
        const int cgp = it % NCG, rb = it / NCG, c = cgp * 8, t0 = rb * RB;
        float wg[3][8], wv[3][8], bg[8], bv[8];
#pragma unroll
        for (int j = 0; j < 3; ++j)
#pragma unroll
            for (int e = 0; e < 8; ++e) { wg[j][e] = cw[j * NUP + c + e]; wv[j][e] = cw[j * NUP + DFF + c + e]; }
#pragma unroll
        for (int e = 0; e < 8; ++e) { bg[e] = cbias[c + e]; bv[e] = cbias[DFF + c + e]; }
        float g2[8], g1[8], v2[8], v1[8];
        const bool first = ((t0 & (SEQ - 1)) == 0);
#pragma unroll
        for (int e = 0; e < 8; ++e) { g2[e] = 0.f; g1[e] = 0.f; v2[e] = 0.f; v1[e] = 0.f; }
        if (!first) {
            const u32x4 a = *(const u32x4*)(up + (size_t)(t0 - 2) * NUP + c), b2 = *(const u32x4*)(up + (size_t)(t0 - 1) * NUP + c);
            const u32x4 cc = *(const u32x4*)(up + (size_t)(t0 - 2) * NUP + DFF + c), d = *(const u32x4*)(up + (size_t)(t0 - 1) * NUP + DFF + c);
            g2[0] = bflo(a.x); g2[1] = bfhi(a.x); g2[2] = bflo(a.y); g2[3] = bfhi(a.y); g2[4] = bflo(a.z); g2[5] = bfhi(a.z); g2[6] = bflo(a.w); g2[7] = bfhi(a.w);
            g1[0] = bflo(b2.x); g1[1] = bfhi(b2.x); g1[2] = bflo(b2.y); g1[3] = bfhi(b2.y); g1[4] = bflo(b2.z); g1[5] = bfhi(b2.z); g1[6] = bflo(b2.w); g1[7] = bfhi(b2.w);
            v2[0] = bflo(cc.x); v2[1] = bfhi(cc.x); v2[2] = bflo(cc.y); v2[3] = bfhi(cc.y); v2[4] = bflo(cc.z); v2[5] = bfhi(cc.z); v2[6] = bflo(cc.w); v2[7] = bfhi(cc.w);
            v1[0] = bflo(d.x); v1[1] = bfhi(d.x); v1[2] = bflo(d.y); v1[3] = bfhi(d.y); v1[4] = bflo(d.z); v1[5] = bfhi(d.z); v1[6] = bflo(d.w); v1[7] = bfhi(d.w);
        }
#pragma unroll 4
        for (int rr = 0; rr < RB; ++rr) {
            const int t = t0 + rr;
            const u32x4 a = *(const u32x4*)(up + (size_t)t * NUP + c), d = *(const u32x4*)(up + (size_t)t * NUP + DFF + c);
            float g0[8] = {bflo(a.x), bfhi(a.x), bflo(a.y), bfhi(a.y), bflo(a.z), bfhi(a.z), bflo(a.w), bfhi(a.w)};
            float v0[8] = {bflo(d.x), bfhi(d.x), bflo(d.y), bfhi(d.y), bflo(d.z), bfhi(d.z), bflo(d.w), bfhi(d.w)};
            float o[8];
#pragma unroll
            for (int e = 0; e < 8; ++e) {
                const float G = wg[0][e] * g2[e] + wg[1][e] * g1[e] + wg[2][e] * g0[e] + bg[e];
                const float V = wv[0][e] * v2[e] + wv[1][e] * v1[e] + wv[2][e] * v0[e] + bv[e];
                o[e] = silu_f(G) * V; g2[e] = g1[e]; g1[e] = g0[e]; v2[e] = v1[e]; v1[e] = v0[e];
            }
            u32x4 w; w.x = pk2(o[0], o[1]); w.y = pk2(o[2], o[3]); w.z = pk2(o[4], o[5]); w.w = pk2(o[6], o[7]);
            *(u32x4*)(act + (size_t)t * DFF + c) = w;
        }
    }
}
__device__ __forceinline__ void final_phase(const Params& p) {
    const float* ssq3 = (const float*)(p.ws + OFF_SSQ3); const float* fw = p.in[I_FNW];
    f32x4* o = (f32x4*)p.out;
    for (int i = blockIdx.x * 512 + threadIdx.x; i < MTOK * DM / 4; i += gridDim.x * 512) {
        const int row = i >> 9, c4 = i & 511;
        const float rs = rsqrtf(ssq3[row] * (1.0f / DM) + EPS);
        const f32x4 w = *(const f32x4*)(fw + 4 * c4);
        o[i] = o[i] * rs * w;
    }
}

constexpr int NPHASE = 9;
template <bool COOP>
__global__ void __launch_bounds__(512, 2) mk_fwd(Params p) {
    extern __shared__ __attribute__((aligned(16))) unsigned char lds_raw[];
    LAS unsigned char* lds = (LAS unsigned char*)lds_raw;
    unsigned char* ws = p.ws;
    const int lo = p.ph_lo, hi = p.ph_hi;
    const int G = gridDim.x, bid = blockIdx.x;
#define IN(k) (lo <= (k) && (k) < hi)
#define SEAM(k) do { if (COOP) { if ((k) + 1 < hi) cg::this_grid().sync(); } } while (0)
    if (IN(0)) { phase_prep(p, lds); SEAM(0); }
    if (IN(1)) {
        pg8::Gemm g{(const bf16_t*)(ws + OFF_XB), (const bf16_t*)(ws + OFF_WIN), MTOK, N1, DM, DM, DM, 0};
        pg8::StaticOrder S; S.init(MTOK, N1, G, bid);
        EpiProj E{(bf16_t*)(ws + OFF_PROJ), (float*)(ws + OFF_LOGIT), (const float*)(ws + OFF_RSTD1)};
        pg8::gemm_phase<EpiProj>(lds, g, S, E);
        SEAM(1);
    }
    if (IN(2)) {
        for (int item = bid; item < 1024; item += G) chunk_prep(p, lds, item);
        pool_diff(p);
        SEAM(2);
    }
    if (IN(3)) {
        if (bid < 32) scan_phase(p, lds, bid);
        else {
            pg8::Gemm g{(const bf16_t*)(ws + OFF_DPOOL), (const bf16_t*)(ws + OFF_POOLT), MTOK, 1024, 256, 1024, 256, 512};
            pg8::StaticOrder S; S.init(MTOK, 1024, G - 32, bid - 32);
            EpiBf E{(bf16_t*)(ws + OFF_MIX), DM, 1024, nullptr};
            pg8::gemm_phase<EpiBf>(lds, g, S, E);
        }
        SEAM(3);
    }
    if (IN(4)) {
        pg8::Gemm g{(const bf16_t*)(ws + OFF_MIX), (const bf16_t*)(ws + OFF_WOUT), MTOK, DM, DM, DM, DM, 0};
        pg8::StaticOrder S; S.init(MTOK, DM, G, bid);
        EpiRes E{p.in[I_X], p.out, (bf16_t*)(ws + OFF_XB), (float*)(ws + OFF_SSQ2)};
        pg8::gemm_phase<EpiRes>(lds, g, S, E);
        SEAM(4);
    }
    if (IN(5)) {
        pg8::Gemm g{(const bf16_t*)(ws + OFF_XB), (const bf16_t*)(ws + OFF_WUP), MTOK, NUP, DM, DM, DM, 0};
        pg8::StaticOrder S; S.init(MTOK, NUP, G, bid);
        EpiBf E{(bf16_t*)(ws + OFF_UP), NUP, 0, (const float*)(ws + OFF_SSQ2)};
        pg8::gemm_phase<EpiBf>(lds, g, S, E);
        SEAM(5);
    }
    if (IN(6)) { act_phase(p); SEAM(6); }
    if (IN(7)) {
        pg8::Gemm g{(const bf16_t*)(ws + OFF_ACT), (const bf16_t*)(ws + OFF_WDOWN), MTOK, DM, DFF, DFF, DFF, 0};
        pg8::StaticOrder S; S.init(MTOK, DM, G, bid);
        EpiRes E{p.out, p.out, nullptr, (float*)(ws + OFF_SSQ3)};
        pg8::gemm_phase<EpiRes>(lds, g, S, E);
        SEAM(7);
    }
    if (IN(8)) { final_phase(p); }
#undef IN
#undef SEAM
}

extern "C" void kernel_launch(void* const* d_in, const int* in_sizes, int n_in, void* d_out, int out_size, void* d_ws, size_t ws_size, hipStream_t stream) {
    static int grid = 0;
    if (!grid) {
        if (n_in != 16 || out_size != MTOK * DM || ws_size < WS_END) { fprintf(stderr, "kernel_launch: unexpected shapes (n_in %d out %d ws %zu, need %zu)\n", n_in, out_size, ws_size, (size_t)WS_END); grid = -1; return; }
        int dev = 0, cus = 0, per_cu = 0;
        hipGetDevice(&dev); hipDeviceGetAttribute(&cus, hipDeviceAttributeMultiprocessorCount, dev);
#if ONE_LAUNCH
        hipFuncSetAttribute((const void*)mk_fwd<true>, hipFuncAttributeMaxDynamicSharedMemorySize, LDS_BYTES);
        hipOccupancyMaxActiveBlocksPerMultiprocessor(&per_cu, mk_fwd<true>, 512, LDS_BYTES);
#else
        hipFuncSetAttribute((const void*)mk_fwd<false>, hipFuncAttributeMaxDynamicSharedMemorySize, LDS_BYTES);
        hipOccupancyMaxActiveBlocksPerMultiprocessor(&per_cu, mk_fwd<false>, 512, LDS_BYTES);
#endif
        if (per_cu < 1) per_cu = 1;
        grid = cus * per_cu;
        if (grid < 64) { fprintf(stderr, "kernel_launch: grid %d too small\n", grid); grid = -1; return; }
    }
    if (grid < 0) return;
    Params p{};
    for (int i = 0; i < 16; ++i) p.in[i] = (const float*)d_in[i];
    p.out = (float*)d_out; p.ws = (unsigned char*)d_ws;
#if ONE_LAUNCH
    p.ph_lo = 0; p.ph_hi = NPHASE;
    void* args[] = {&p};
    hipError_t e = hipLaunchCooperativeKernel((const void*)mk_fwd<true>, dim3(grid), dim3(512), args, LDS_BYTES, stream);
    if (e != hipSuccess) fprintf(stderr, "cooperative launch failed: %s (grid %d)\n", hipGetErrorString(e), grid);
#else
    for (int ph = 0; ph < NPHASE; ++ph) { p.ph_lo = ph; p.ph_hi = ph + 1; hipLaunchKernelGGL(mk_fwd<false>, dim3(grid), dim3(512), LDS_BYTES, stream, p); }
#endif
}
```

```cpp
#include <hip/hip_runtime.h>
#include <hip/hip_cooperative_groups.h>
#include <cstdio>
#include <cstdint>
namespace cg = cooperative_groups;

#ifndef ONE_LAUNCH
#define ONE_LAUNCH 1
#endif

#ifndef PLIST
#define PLIST 0,1,2,3,4,5,6,7,8
#endif
#define LAS __attribute__((address_space(3)))
typedef unsigned short bf16_t;
typedef short bf16x8 __attribute__((ext_vector_type(8)));
typedef float f32x4 __attribute__((ext_vector_type(4)));
typedef float f32x2 __attribute__((ext_vector_type(2)));
typedef float f32x16 __attribute__((ext_vector_type(16)));
typedef unsigned u32x4 __attribute__((ext_vector_type(4)));
typedef unsigned u32x2 __attribute__((ext_vector_type(2)));
typedef __bf16 bf16x2_t __attribute__((ext_vector_type(2)));

__device__ __forceinline__ unsigned pk2(float lo, float hi) { f32x2 v = {lo, hi}; bf16x2_t r = __builtin_convertvector(v, bf16x2_t); return __builtin_bit_cast(unsigned, r); }
__device__ __forceinline__ float bflo(unsigned w) { return __uint_as_float(w << 16); }
__device__ __forceinline__ float bfhi(unsigned w) { return __uint_as_float(w & 0xffff0000u); }
__device__ __forceinline__ float silu_f(float x) { return x / (1.0f + __expf(-x)); }

constexpr int SEQ = 2048, DM = 2048, MTOK = 8192;
constexpr int NH = 8, HD = 128, CH = 64, NCH = SEQ / CH;
constexpr int DFF = 5632, NUP = 2 * DFF;
constexpr int INW = 5136, NPROJ = 5120, N1 = 5376;
constexpr float EPS = 1e-6f;

constexpr size_t OFF_WIN = 0;
constexpr size_t OFF_WOUT = OFF_WIN + (size_t)N1 * DM * 2;
constexpr size_t OFF_WUP = OFF_WOUT + (size_t)DM * DM * 2;
constexpr size_t OFF_XB = OFF_WUP + (size_t)NUP * DM * 2;
constexpr size_t OFF_ACT = 0;
constexpr size_t OFF_WDOWN = OFF_XB + (size_t)MTOK * DM * 2;
constexpr size_t OFF_POOLT = OFF_WDOWN + (size_t)DM * DFF * 2;
constexpr size_t OFF_LOGIT = OFF_POOLT + 4 * 256 * 256 * 2;
constexpr size_t OFF_RSTD1 = OFF_LOGIT + (size_t)MTOK * 16 * 4;
constexpr size_t OFF_SSQ2 = OFF_RSTD1 + MTOK * 4;
constexpr size_t OFF_SSQ3 = OFF_SSQ2 + MTOK * 4;
constexpr size_t OFF_GLAST = OFF_SSQ3 + MTOK * 4;
constexpr size_t OFF_BAR = OFF_GLAST + 4096;
constexpr size_t OFF_B = ((OFF_BAR + 16384 + 1048575) / 1048576) * 1048576;
constexpr size_t OFF_UP = OFF_B;
constexpr size_t OFF_PROJ = OFF_B;
constexpr size_t CHUNK_BYTES = 32768 + 16384 * 3 + 8192;
constexpr size_t OFF_CHUNK = OFF_PROJ + (size_t)MTOK * NPROJ * 2;
constexpr size_t OFF_DPOOL = OFF_CHUNK + 1024 * CHUNK_BYTES;
constexpr size_t OFF_MIX = OFF_DPOOL + (size_t)MTOK * 1024 * 2;
constexpr size_t WS_END = OFF_MIX + (size_t)MTOK * DM * 2;
static_assert(OFF_ACT + (size_t)MTOK * DFF * 2 <= OFF_WDOWN, "act overlay");
static_assert(OFF_UP + (size_t)MTOK * NUP * 2 <= WS_END, "up overlay");

constexpr int LDS_BYTES = 147456, LDS_MISC = 147200;
static_assert(WS_END <= 369098752, "workspace budget");


#define XB_TMO      128
#define XB_XCNT(j)  (256  + 64 * (j))
#define XB_XSUB(j)  (1280 + 64 * (j))
#define XB_XGEN(j)  (2304 + 64 * (j))
#define XB_TOP      3328
#define XB_TOPGEN   3392
#define XCD_BAR_WORDS 3456
#define XB_SPIN_CAP (1u << 18)
__device__ __forceinline__ unsigned xb_ld(unsigned* p)              { return __hip_atomic_load(p, __ATOMIC_RELAXED, __HIP_MEMORY_SCOPE_AGENT); }
__device__ __forceinline__ unsigned xb_add(unsigned* p, unsigned v) { return __hip_atomic_fetch_add(p, v, __ATOMIC_RELAXED, __HIP_MEMORY_SCOPE_AGENT); }
__device__ __forceinline__ unsigned xb_xcc_id() { return (unsigned)__builtin_amdgcn_s_getreg((3 << 11) | 20) & 0xFu; }
#define XB_SPIN(cond, bar) do { unsigned _sp = 0; while (cond) { __builtin_amdgcn_s_sleep(1); \
    if ((++_sp & 255u) == 0u) { if (xb_ld(&(bar)[XB_TMO])) break; if (_sp > XB_SPIN_CAP) { atomicAdd(&(bar)[XB_TMO], 1u); break; } } } } while (0)
struct XcdBarrier { unsigned* bar; unsigned x; volatile LAS unsigned* st; };
__device__ __forceinline__ XcdBarrier xcd_barrier_post(unsigned* bar, volatile LAS unsigned* st) {
    XcdBarrier b; b.bar = bar; b.x = xb_xcc_id(); b.st = st;
    if (threadIdx.x == 0) (void)xb_add(&bar[XB_XCNT(b.x)], 1u);
    return b;
}
__device__ __forceinline__ void xcd_barrier_complete(unsigned* bar, unsigned x, unsigned& nloc, unsigned& nx) {
    const unsigned G = gridDim.x * gridDim.y * gridDim.z;
    unsigned sum, cnt, mine, sp = 0u;
    for (;;) {
        sum = 0u; cnt = 0u; mine = 0u;
#pragma unroll
        for (unsigned j = 0; j < 16; ++j) { const unsigned c = xb_ld(&bar[XB_XCNT(j)]); sum += c; cnt += (c > 0u) ? 1u : 0u; mine = (j == x) ? c : mine; }
        if (sum == G) break;
        __builtin_amdgcn_s_sleep(1);
        if ((++sp & 255u) == 0u) { if (xb_ld(&bar[XB_TMO])) break; if (sp > XB_SPIN_CAP) { atomicAdd(&bar[XB_TMO], 1u); break; } }
    }
    nloc = mine > 0u ? mine : 1u; nx = cnt > 0u ? cnt : 1u;
}
__device__ __forceinline__ void xcd_barrier(const XcdBarrier& b) {
    asm volatile("s_waitcnt vmcnt(0)" ::: "memory");
    __syncthreads();
    if (threadIdx.x == 0) {
        unsigned* bar = b.bar;
        __builtin_amdgcn_s_waitcnt(0);
        unsigned nloc = b.st[0], nx = b.st[1];
        if (nloc == 0u) { xcd_barrier_complete(bar, b.x, nloc, nx); b.st[0] = nloc; b.st[1] = nx; }
        const unsigned old = xb_add(&bar[XB_XSUB(b.x)], 1u);
        const unsigned gen = old / nloc;
        if (old + 1u == (gen + 1u) * nloc) {
            __builtin_amdgcn_fence(__ATOMIC_RELEASE, "agent");
            asm volatile("s_waitcnt vmcnt(0)" ::: "memory");
            const unsigned og = xb_add(&bar[XB_TOP], 1u);
            const unsigned tg = og / nx;
            if (og + 1u == (tg + 1u) * nx) xb_add(&bar[XB_TOPGEN], 1u);
            else XB_SPIN(xb_ld(&bar[XB_TOPGEN]) == tg, bar);
            __builtin_amdgcn_fence(__ATOMIC_ACQUIRE, "agent");
            xb_add(&bar[XB_XGEN(b.x)], 1u);
            asm volatile("s_waitcnt vmcnt(0)" ::: "memory");
        } else {
            XB_SPIN(xb_ld(&bar[XB_XGEN(b.x)]) == gen, bar);
            __builtin_amdgcn_fence(__ATOMIC_ACQUIRE, "agent");
            asm volatile("s_waitcnt vmcnt(0)" ::: "memory");
        }
    }
    __syncthreads();
}

namespace pg8 {
constexpr int BM = 256, BK = 64, HALF = 128, HTB = HALF * BK * 2, NXCD = 8, WGM = 8;
__host__ __device__ __forceinline__ int lds_byte(int r, int c) { const int st = (r >> 4) * 2 + (c >> 5), rr = r & 15, cc = c & 31, ob = rr * 64 + cc * 2; return st * 1024 + (ob ^ (((ob >> 9) & 1) << 5)); }
__host__ __device__ __forceinline__ void stage_rc(int b, int& R, int& C) { const int st = b / 1024, sb = b % 1024, swz = sb ^ (((sb >> 9) & 1) << 5); R = (st >> 1) * 16 + swz / 64; C = (st & 1) * 32 + (swz % 64) / 2; }
__host__ __device__ __forceinline__ int perm32(int rho) { const int n = rho >> 4, i = rho & 15; return 8 * (i >> 2) + 4 * n + (i & 3); }

struct Unit { int pm, pn; };
struct Gemm { const bf16_t* A; const bf16_t* Bt; int M, N, K, lda, ldb, a_pn_off; };

struct StaticOrder {
    int nM, nN, nwg, G, c;
    __host__ __device__ void init(int M, int N, int G_, int c_) { nM = M / BM; nN = N / BM; nwg = nM * nN; G = G_; c = c_; }
    __host__ __device__ bool next(int i, Unit& u) const {
        if (c < 0) return false;
        const long L = (long)i * G + c; if (L >= nwg) return false;
        int wgid = (int)L; { const int q = nwg / NXCD, r = nwg % NXCD, xcd = wgid % NXCD, off = wgid / NXCD; wgid = (xcd < r ? xcd * (q + 1) : r * (q + 1) + (xcd - r) * q) + off; }
        const int nig = WGM * nN, gid = wgid / nig, fm = gid * WGM, gsz = (nM - fm) < WGM ? (nM - fm) : WGM;
        u.pm = fm + ((wgid % nig) % gsz); u.pn = (wgid % nig) / gsz; return true;
    }
};

template <class Epi>
__device__ __forceinline__ void gemm_phase(LAS unsigned char* lds, const Gemm g, const StaticOrder& S, const Epi& E) {
    const int tid = threadIdx.x, wid = __builtin_amdgcn_readfirstlane(tid >> 6), lane = tid & 63, wr = wid >> 2, wc = wid & 3, fr = lane & 15, fq = lane >> 4;
    const int K = g.K, nt = K / BK;
    unsigned voffA[2], voffB[2];
#pragma unroll
    for (int i = 0; i < 2; ++i) { int R, C; stage_rc(tid * 16 + i * 8192, R, C); const int Rb = Epi::PERM ? ((R & ~31) + perm32(R & 31)) : R;
        voffA[i] = (unsigned)(R * g.lda + C) * 2u; voffB[i] = (unsigned)(Rb * g.ldb + C) * 2u; }
    const size_t kstep = (size_t)(BK * 2);
    const size_t hstepA = (size_t)HALF * g.lda * 2, hstepB = (size_t)HALF * g.ldb * 2;
    const size_t tstepA = 2 * hstepA, tstepB = 2 * hstepB;
    const unsigned ldsw = (unsigned)wid * 1024u;
    const int aoff = lds_byte(wr * 64 + fr, fq * 8), boff = lds_byte(wc * 32 + fr, fq * 8);
#define PG8_SA(b, h) (((b) * 2 + (h)) * HTB)
#define PG8_SB(b, h) ((4 + (b) * 2 + (h)) * HTB)
#define PG8_STAGE(bufoff, gbase, voff) do { _Pragma("unroll") for (int _i = 0; _i < 2; ++_i) \
        __builtin_amdgcn_global_load_lds((const unsigned*)((const char*)(gbase) + (voff)[_i]), (LAS unsigned*)(lds + (bufoff) + ldsw + _i * 8192), 16, 0, 0); } while (0)
#define PG8_LDA(dst, b, h) do { _Pragma("unroll") for (int m = 0; m < 4; ++m) _Pragma("unroll") for (int k = 0; k < 2; ++k) dst[m][k] = *(const LAS bf16x8*)(lds + PG8_SA(b, h) + aoff + m * 2048 + k * 1024); } while (0)
#define PG8_LDB(dst, b, h) do { _Pragma("unroll") for (int n = 0; n < 2; ++n) _Pragma("unroll") for (int k = 0; k < 2; ++k) dst[n][k] = *(const LAS bf16x8*)(lds + PG8_SB(b, h) + boff + n * 2048 + k * 1024); } while (0)
#define PG8_MMA(ai, bj, At, Bt) do { __builtin_amdgcn_s_setprio(1); _Pragma("unroll") for (int m = 0; m < 4; ++m) _Pragma("unroll") for (int n = 0; n < 2; ++n) _Pragma("unroll") for (int k = 0; k < 2; ++k) \
        acc[ai][bj][m][n] = __builtin_amdgcn_mfma_f32_16x16x32_bf16(Bt[n][k], At[m][k], acc[ai][bj][m][n], 0, 0, 0); __builtin_amdgcn_s_setprio(0); } while (0)
#define PG8_WAIT_V(n) asm volatile("s_waitcnt vmcnt(" #n ")" ::: "memory")
#define PG8_WAIT_L(n) asm volatile("s_waitcnt lgkmcnt(" #n ")" ::: "memory")
#define PG8_BAR __builtin_amdgcn_s_barrier()
#define PG8_SCHED __builtin_amdgcn_sched_barrier(0)
    Unit cur, nxt; int ui = 0;
    if (!S.next(0, cur)) return;
    f32x4 acc[2][2][4][2];
#pragma unroll
    for (int a = 0; a < 2; ++a)
#pragma unroll
        for (int b = 0; b < 2; ++b)
#pragma unroll
            for (int m = 0; m < 4; ++m)
#pragma unroll
                for (int n = 0; n < 2; ++n) acc[a][b][m][n] = (f32x4){0.f, 0.f, 0.f, 0.f};
    bf16x8 At[4][2], B0[2][2], B1[2][2];
    const char* cA = (const char*)g.A + (size_t)cur.pm * tstepA + (size_t)cur.pn * g.a_pn_off; const char* cB = (const char*)g.Bt + (size_t)cur.pn * tstepB;
    PG8_STAGE(PG8_SB(0, 0), cB, voffB); PG8_STAGE(PG8_SB(0, 1), cB + hstepB, voffB); PG8_STAGE(PG8_SA(0, 0), cA, voffA); PG8_STAGE(PG8_SA(0, 1), cA + hstepA, voffA);
    if (wr == 1) PG8_BAR;
    PG8_WAIT_V(2); PG8_BAR;
    PG8_STAGE(PG8_SB(1, 0), cB + kstep, voffB); PG8_STAGE(PG8_SA(1, 0), cA + kstep, voffA); PG8_STAGE(PG8_SB(1, 1), cB + hstepB + kstep, voffB);
    PG8_WAIT_V(6); PG8_BAR;
    for (;;) {
        const bool has_next = S.next(ui + 1, nxt);
        const char* nA = has_next ? (const char*)g.A + (size_t)nxt.pm * tstepA + (size_t)nxt.pn * g.a_pn_off : cA; const char* nB = has_next ? (const char*)g.Bt + (size_t)nxt.pn * tstepB : cB;
        for (int t = 0; t < nt; t += 2) {
            const bool last = (t == nt - 2);
            const char* a1 = cA + (size_t)(t + 1) * kstep;
            const char* a2 = last ? nA : cA + (size_t)(t + 2) * kstep; const char* b2 = last ? nB : cB + (size_t)(t + 2) * kstep;
            const char* a3 = a2 + kstep; const char* b3 = b2 + kstep;
            PG8_LDB(B0, 0, 0); PG8_LDB(B1, 0, 1); PG8_SCHED; PG8_LDA(At, 0, 0); PG8_STAGE(PG8_SA(1, 1), a1 + hstepA, voffA);
            PG8_WAIT_V(8); PG8_WAIT_L(0); PG8_BAR; PG8_MMA(0, 0, At, B0); PG8_MMA(0, 1, At, B1); PG8_BAR; PG8_SCHED;
            PG8_LDA(At, 0, 1); PG8_STAGE(PG8_SB(0, 0), b2, voffB); PG8_STAGE(PG8_SB(0, 1), b2 + hstepB, voffB); PG8_STAGE(PG8_SA(0, 0), a2, voffA);
            PG8_WAIT_V(8); PG8_WAIT_L(0); PG8_BAR; PG8_MMA(1, 0, At, B0); PG8_MMA(1, 1, At, B1); PG8_BAR; PG8_SCHED;
            PG8_LDB(B0, 1, 0); PG8_LDB(B1, 1, 1); PG8_SCHED; PG8_LDA(At, 1, 0); PG8_STAGE(PG8_SA(0, 1), a2 + hstepA, voffA);
            PG8_WAIT_V(8); PG8_WAIT_L(0); PG8_BAR; PG8_MMA(0, 0, At, B0); PG8_MMA(0, 1, At, B1); PG8_BAR; PG8_SCHED;
            PG8_LDA(At, 1, 1); PG8_STAGE(PG8_SB(1, 0), b3, voffB); PG8_STAGE(PG8_SB(1, 1), b3 + hstepB, voffB); PG8_STAGE(PG8_SA(1, 0), a3, voffA);
            PG8_WAIT_V(8); PG8_WAIT_L(0); PG8_BAR; PG8_MMA(1, 0, At, B0); PG8_MMA(1, 1, At, B1); PG8_BAR; PG8_SCHED;
        }
        if (wr == 0) PG8_BAR;
        E(acc, cur, wr, wc, fr, fq);
        if (!has_next) break;
#pragma unroll
        for (int a = 0; a < 2; ++a)
#pragma unroll
            for (int b = 0; b < 2; ++b)
#pragma unroll
                for (int m = 0; m < 4; ++m)
#pragma unroll
                    for (int n = 0; n < 2; ++n) acc[a][b][m][n] = (f32x4){0.f, 0.f, 0.f, 0.f};
        cur = nxt; cA = nA; cB = nB; ++ui;
        if (wr == 1) PG8_BAR;
    }
    PG8_WAIT_V(0);
    PG8_BAR;
#undef PG8_SA
#undef PG8_SB
#undef PG8_STAGE
#undef PG8_LDA
#undef PG8_LDB
#undef PG8_MMA
#undef PG8_WAIT_V
#undef PG8_WAIT_L
#undef PG8_BAR
#undef PG8_SCHED
}
}

struct EpiProj {
    static constexpr bool PERM = true;
    bf16_t* P; float* logits; const float* rstd;
    __device__ __forceinline__ void operator()(const f32x4 (&acc)[2][2][4][2], const pg8::Unit& u, int wr, int wc, int fr, int fq) const {
        const int row0 = u.pm * 256 + wr * 64 + fr;
        if (u.pn < 20) {
            const int col0 = u.pn * 256 + wc * 32 + 8 * fq;
#pragma unroll
            for (int ai = 0; ai < 2; ++ai)
#pragma unroll
                for (int m = 0; m < 4; ++m) { const int row = row0 + ai * 128 + m * 16; const float rs = rstd[row]; bf16_t* rowp = P + (size_t)row * NPROJ + col0;
#pragma unroll
                    for (int bj = 0; bj < 2; ++bj) { const f32x4 v0 = acc[ai][bj][m][0] * rs, v1 = acc[ai][bj][m][1] * rs;
                        u32x4 w; w.x = pk2(v0[0], v0[1]); w.y = pk2(v0[2], v0[3]); w.z = pk2(v1[0], v1[1]); w.w = pk2(v1[2], v1[3]);
                        *(u32x4*)(rowp + bj * 128) = w; } }
        } else if (wc == 0 && fq < 2) {
#pragma unroll
            for (int ai = 0; ai < 2; ++ai)
#pragma unroll
                for (int m = 0; m < 4; ++m) { const int row = row0 + ai * 128 + m * 16; const float rs = rstd[row]; float* lp = logits + (size_t)row * 16 + 8 * fq;
                    *(f32x4*)lp = acc[ai][0][m][0] * rs; *(f32x4*)(lp + 4) = acc[ai][0][m][1] * rs; }
        }
    }
};
struct EpiBf {
    static constexpr bool PERM = true;
    bf16_t* O; int ldc; int colbase; const float* ssq;
    __device__ __forceinline__ void operator()(const f32x4 (&acc)[2][2][4][2], const pg8::Unit& u, int wr, int wc, int fr, int fq) const {
        const int row0 = u.pm * 256 + wr * 64 + fr; const int col0 = colbase + u.pn * 256 + wc * 32 + 8 * fq;
#pragma unroll
        for (int ai = 0; ai < 2; ++ai)
#pragma unroll
            for (int m = 0; m < 4; ++m) { const int row = row0 + ai * 128 + m * 16; const float rs = ssq ? rsqrtf(ssq[row] * (1.0f / DM) + EPS) : 1.0f; bf16_t* rowp = O + (size_t)row * ldc + col0;
#pragma unroll
                for (int bj = 0; bj < 2; ++bj) { const f32x4 v0 = acc[ai][bj][m][0] * rs, v1 = acc[ai][bj][m][1] * rs;
                    u32x4 w; w.x = pk2(v0[0], v0[1]); w.y = pk2(v0[2], v0[3]); w.z = pk2(v1[0], v1[1]); w.w = pk2(v1[2], v1[3]);
                    *(u32x4*)(rowp + bj * 128) = w; } }
    }
};
struct EpiRes {
    static constexpr bool PERM = false;
    const float* base; float* out; bf16_t* ob; float* ssq;
    __device__ __forceinline__ void operator()(const f32x4 (&acc)[2][2][4][2], const pg8::Unit& u, int wr, int wc, int fr, int fq) const {
        const int row0 = u.pm * 256 + wr * 64 + fr, col0 = u.pn * 256 + wc * 32 + 4 * fq;
#pragma unroll
        for (int ai = 0; ai < 2; ++ai)
#pragma unroll
            for (int m = 0; m < 4; ++m) { const int row = row0 + ai * 128 + m * 16; const size_t off = (size_t)row * DM + col0; float ss = 0.f;
#pragma unroll
                for (int bj = 0; bj < 2; ++bj)
#pragma unroll
                    for (int n = 0; n < 2; ++n) { const f32x4 b = *(const f32x4*)(base + off + bj * 128 + n * 16); const f32x4 v = b + acc[ai][bj][m][n];
                        *(f32x4*)(out + off + bj * 128 + n * 16) = v; ss += (v[0] * v[0] + v[1] * v[1]) + (v[2] * v[2] + v[3] * v[3]);
                        if (ob) { u32x2 w; w.x = pk2(v[0], v[1]); w.y = pk2(v[2], v[3]); *(u32x2*)(ob + off + bj * 128 + n * 16) = w; } }
                ss += __shfl_xor(ss, 16); ss += __shfl_xor(ss, 32);
                if (fq == 0) atomicAdd(ssq + row, ss);
                asm volatile("" ::: "memory"); }
    }
};

struct Params { const float* in[16]; float* out; unsigned char* ws; int ph_lo, ph_hi; };
enum { I_X = 0, I_N1W, I_WIN, I_CONVQ, I_ALOG, I_DTB, I_ONW, I_POOLW, I_POOLS, I_WOUT, I_N2W, I_WUP, I_CONVF, I_CONVFB, I_WDOWN, I_FNW };

__device__ __forceinline__ void tr_item(const float* W, int ldw, int col0, int nvalid, bf16_t* WT, int ldk, int row0, int k0, const float* kscale, const float* nscale, LAS float* scr, int lane) {
    const int n = lane & 31;
#pragma unroll 8
    for (int i = 0; i < 32; ++i) { const int kk = 2 * i + (lane >> 5); float v = (n < nvalid) ? W[(size_t)(k0 + kk) * ldw + col0 + n] : 0.f; if (kscale) v *= kscale[k0 + kk]; scr[kk * 33 + n] = v; }
    asm volatile("s_waitcnt lgkmcnt(0)" ::: "memory");
    const int c = lane & 7;
#pragma unroll
    for (int j = 0; j < 4; ++j) { const int nn = (lane >> 3) + 8 * j; const LAS float* s = scr + (8 * c) * 33 + nn; const float sc = nscale ? nscale[nn] : 1.0f;
        u32x4 o; o.x = pk2(s[0 * 33] * sc, s[1 * 33] * sc); o.y = pk2(s[2 * 33] * sc, s[3 * 33] * sc); o.z = pk2(s[4 * 33] * sc, s[5 * 33] * sc); o.w = pk2(s[6 * 33] * sc, s[7 * 33] * sc);
        *(u32x4*)(WT + (size_t)(row0 + nn) * ldk + k0 + 8 * c) = o; }
    asm volatile("s_waitcnt lgkmcnt(0)" ::: "memory");
}

__device__ __forceinline__ void tr64_item(const float* W, int ldw, int col0, bf16_t* WT, int ldk, int row0, int k0, const float* kscale, const float* nscale, LAS float* scr, int lane) {
    f32x4 v[16];
    const int l15 = lane & 15, lq = lane >> 4;
#pragma unroll
    for (int i = 0; i < 16; ++i) v[i] = *(const f32x4*)(W + (size_t)(k0 + 4 * i + lq) * ldw + col0 + 4 * l15);
    if (kscale) {
#pragma unroll
        for (int i = 0; i < 16; ++i) v[i] = v[i] * kscale[k0 + 4 * i + lq];
    }
#pragma unroll
    for (int i = 0; i < 16; ++i) { LAS float* d = scr + (4 * i + lq) * 65 + 4 * l15; d[0] = v[i][0]; d[1] = v[i][1]; d[2] = v[i][2]; d[3] = v[i][3]; }
    asm volatile("s_waitcnt lgkmcnt(0)" ::: "memory");
    const int c = lane & 7;
#pragma unroll
    for (int j = 0; j < 8; ++j) { const int nn = (lane >> 3) + 8 * j; const LAS float* sp = scr + (8 * c) * 65 + nn; const float sc = nscale ? nscale[nn] : 1.0f;
        u32x4 o; o.x = pk2(sp[0 * 65] * sc, sp[1 * 65] * sc); o.y = pk2(sp[2 * 65] * sc, sp[3 * 65] * sc); o.z = pk2(sp[4 * 65] * sc, sp[5 * 65] * sc); o.w = pk2(sp[6 * 65] * sc, sp[7 * 65] * sc);
        *(u32x4*)(WT + (size_t)(row0 + nn) * ldk + k0 + 8 * c) = o; }
    asm volatile("s_waitcnt lgkmcnt(0)" ::: "memory");
}
__device__ __forceinline__ float wave_sum(float v) {
#pragma unroll
    for (int o = 1; o < 64; o <<= 1) v += __shfl_xor(v, o);
    return v;
}
__device__ __forceinline__ void phase_prep(const Params& p, LAS unsigned char* lds) {
    const int tid = threadIdx.x, lane = tid & 63, wave = tid >> 6;
    const int gw = blockIdx.x * 8 + wave, NGW = gridDim.x * 8;
    unsigned char* ws = p.ws;
    LAS float* scr = (LAS float*)(lds + wave * 16640);
    bf16_t* WinT = (bf16_t*)(ws + OFF_WIN); bf16_t* WoutT = (bf16_t*)(ws + OFF_WOUT); bf16_t* PoolT = (bf16_t*)(ws + OFF_POOLT);
    constexpr int I_A = 32 * 64, I_B = 32 * 16, I_C = 32, I_O = 32 * 32, I_P = 64;
    constexpr int NIT = I_A + I_B + I_C + I_O + I_P;
    for (int it = gw; it < NIT; it += NGW) {
        int r = it;
        if (r < I_A) { const int kb = r / 64, nb = r % 64; tr64_item(p.in[I_WIN], INW, 64 * nb, WinT, DM, 64 * nb, 64 * kb, p.in[I_N1W], nullptr, scr, lane); continue; } r -= I_A;
        if (r < I_B) { const int kb = r / 16, nb = r % 16; tr64_item(p.in[I_WIN], INW, 4112 + 64 * nb, WinT, DM, 4096 + 64 * nb, 64 * kb, p.in[I_N1W], nullptr, scr, lane); continue; } r -= I_B;
        if (r < I_C) { tr_item(p.in[I_WIN], INW, 4096, 16, WinT, DM, 5120, 64 * r, p.in[I_N1W], nullptr, scr, lane); continue; } r -= I_C;
        if (r < I_O) { const int kb = r / 32, nb = r % 32; tr64_item(p.in[I_WOUT], DM, 64 * nb, WoutT, DM, 64 * nb, 64 * kb, nullptr, nullptr, scr, lane); continue; } r -= I_O;
        { const int g = r / 16, kb = (r % 16) / 4, nb = r % 4; tr64_item(p.in[I_POOLW] + (size_t)g * 65536, 256, 64 * nb, PoolT + (size_t)g * 65536, 256, 64 * nb, 64 * kb, nullptr, p.in[I_POOLS] + g * 256 + 64 * nb, scr, lane); }
    }
    { u32x4* z = (u32x4*)(WinT + (size_t)5152 * DM); const int nz = (N1 - 5152) * DM / 8;
      for (int i = blockIdx.x * 512 + tid; i < nz; i += gridDim.x * 512) z[i] = (u32x4){0u, 0u, 0u, 0u}; }
    { float* z = (float*)(ws + OFF_SSQ2); for (int i = blockIdx.x * 512 + tid; i < 2 * MTOK; i += gridDim.x * 512) z[i] = 0.f; }
    bf16_t* XB = (bf16_t*)(ws + OFF_XB); float* rstd1 = (float*)(ws + OFF_RSTD1);
    for (int m = gw; m < MTOK; m += NGW) {
        const f32x4* xr = (const f32x4*)(p.in[I_X] + (size_t)m * DM) + lane; f32x4 v[8]; float s = 0.f;
#pragma unroll
        for (int j = 0; j < 8; ++j) { v[j] = xr[64 * j]; s += (v[j][0] * v[j][0] + v[j][1] * v[j][1]) + (v[j][2] * v[j][2] + v[j][3] * v[j][3]); }
        s = wave_sum(s);
        if (lane == 0) rstd1[m] = rsqrtf(s * (1.0f / DM) + EPS);
        u32x2* o = (u32x2*)(XB + (size_t)m * DM) + lane;
#pragma unroll
        for (int j = 0; j < 8; ++j) { u32x2 w; w.x = pk2(v[j][0], v[j][1]); w.y = pk2(v[j][2], v[j][3]); o[64 * j] = w; }
    }
}


__device__ __forceinline__ void phase_prep2(const Params& p, LAS unsigned char* lds, int vw, int nvw) {
    const int lane = threadIdx.x & 63, wave = threadIdx.x >> 6;
    LAS float* scr = (LAS float*)(lds + wave * 16640);
    bf16_t* WupT = (bf16_t*)(p.ws + OFF_WUP); bf16_t* WdownT = (bf16_t*)(p.ws + OFF_WDOWN);
    constexpr int I_U = 32 * 176, I_D = 88 * 32;
    for (int it = vw; it < I_U + I_D; it += nvw) {
        if (it < I_U) { const int kb = it / 176, nb = it % 176; tr64_item(p.in[I_WUP], NUP, 64 * nb, WupT, DM, 64 * nb, 64 * kb, p.in[I_N2W], nullptr, scr, lane); }
        else { const int r = it - I_U, kb = r / 32, nb = r % 32; tr64_item(p.in[I_WDOWN], DM, 64 * nb, WdownT, DFF, 64 * nb, 64 * kb, nullptr, nullptr, scr, lane); }
    }
}

constexpr int CP_Q = 0, CP_K = 33792, CP_V = 67584, CP_L = 101376, CP_MISC = 118784;
__device__ __forceinline__ void chunk_prep(const Params& p, LAS unsigned char* lds, int item) {
    const int tid = threadIdx.x, lane = tid & 63, wave = tid >> 6;
    const int b = item >> 8, h = (item >> 5) & 7, n = item & 31;
    const int t0 = b * SEQ + n * CH, tl0 = n * CH;
    unsigned char* ws = p.ws;
    const bf16_t* proj = (const bf16_t*)(ws + OFF_PROJ);
    const float* logits = (const float*)(ws + OFF_LOGIT);
    unsigned char* cb = ws + OFF_CHUNK + (size_t)item * CHUNK_BYTES;
    float* value_o = (float*)cb; bf16_t* kcum_o = (bf16_t*)(cb + 32768); bf16_t* qg_o = (bf16_t*)(cb + 49152); bf16_t* ktT_o = (bf16_t*)(cb + 65536); bf16_t* qk_o = (bf16_t*)(cb + 81920);
    LAS float* qS = (LAS float*)(lds + CP_Q); LAS float* kS = (LAS float*)(lds + CP_K); LAS float* vS = (LAS float*)(lds + CP_V); LAS float* Ls = (LAS float*)(lds + CP_L);
    LAS float* betaS = (LAS float*)(lds + CP_MISC); LAS float* gcS = betaS + 64; LAS float* sclk = betaS + 128; LAS float* egS = betaS + 192; LAS float* etS = betaS + 256;
    const float* cw = p.in[I_CONVQ];
    for (int it = tid; it < 3072; it += 512) {
        const int mat = it >> 10, r = (it & 1023) >> 4, c = (it & 15) * 8;
        const int col = mat * 1024 + h * HD + c;
        float a[8];
#pragma unroll
        for (int e = 0; e < 8; ++e) a[e] = 0.f;
#pragma unroll
        for (int j = 0; j < 4; ++j) {
            if (tl0 + r - 3 + j >= 0) {
                const u32x4 raw = *(const u32x4*)(proj + (size_t)(t0 + r - 3 + j) * NPROJ + col);
                const f32x4 w0 = *(const f32x4*)(cw + j * 3072 + col), w1 = *(const f32x4*)(cw + j * 3072 + col + 4);
                a[0] += w0[0] * bflo(raw.x); a[1] += w0[1] * bfhi(raw.x); a[2] += w0[2] * bflo(raw.y); a[3] += w0[3] * bfhi(raw.y);
                a[4] += w1[0] * bflo(raw.z); a[5] += w1[1] * bfhi(raw.z); a[6] += w1[2] * bflo(raw.w); a[7] += w1[3] * bfhi(raw.w);
            }
        }
        LAS float* dst = (mat == 0 ? qS : (mat == 1 ? kS : vS)) + r * 132 + c;
        *(LAS f32x4*)dst = (f32x4){silu_f(a[0]), silu_f(a[1]), silu_f(a[2]), silu_f(a[3])};
        *(LAS f32x4*)(dst + 4) = (f32x4){silu_f(a[4]), silu_f(a[5]), silu_f(a[6]), silu_f(a[7])};
    }
    __syncthreads();
    {
        const int row = tid >> 2, part = tid & 3;
        LAS float* base = (row < 64 ? qS + row * 132 : kS + (row - 64) * 132) + part * 32;
        f32x4 v[8]; float ss = 0.f;
#pragma unroll
        for (int e = 0; e < 8; ++e) { v[e] = *(LAS f32x4*)(base + 4 * e); ss += (v[e][0] * v[e][0] + v[e][1] * v[e][1]) + (v[e][2] * v[e][2] + v[e][3] * v[e][3]); }
        ss += __shfl_xor(ss, 1); ss += __shfl_xor(ss, 2);
        const float sc = rsqrtf(ss + EPS) * (row < 64 ? 0.08838834764831845f : 1.0f);
#pragma unroll
        for (int e = 0; e < 8; ++e) *(LAS f32x4*)(base + 4 * e) = v[e] * sc;
    }
    if (wave == 0) {
        const float lb = logits[(size_t)(t0 + lane) * 16 + h], la = logits[(size_t)(t0 + lane) * 16 + 8 + h];
        const float beta = 1.0f / (1.0f + __expf(-lb));
        const float x = la + p.in[I_DTB][h];
        const float sp = fmaxf(x, 0.f) + log1pf(__expf(-fabsf(x)));
        float g = -__expf(p.in[I_ALOG][h]) * sp;
#pragma unroll
        for (int o = 1; o < 64; o <<= 1) { const float t = __shfl_up(g, o); if (lane >= o) g += t; }
        const float gl = __shfl(g, 63);
        const float eg = __expf(g);
        betaS[lane] = beta; gcS[lane] = g; sclk[lane] = beta * eg; egS[lane] = eg; etS[lane] = __expf(gl - g);
        if (lane == 63) ((float*)(ws + OFF_GLAST))[item] = eg;
    }
    __syncthreads();
    {
        const int half = tid >> 8, t = tid & 255, ty = t >> 4, tx = t & 15;
        const LAS float* A = half ? qS : kS;
        float acc[4][4];
#pragma unroll
        for (int i = 0; i < 4; ++i)
#pragma unroll
            for (int j = 0; j < 4; ++j) acc[i][j] = 0.f;
#pragma unroll 4
        for (int d = 0; d < HD; d += 4) {
            f32x4 av[4], bv[4];
#pragma unroll
            for (int i = 0; i < 4; ++i) { av[i] = *(const LAS f32x4*)(A + (ty + 16 * i) * 132 + d); bv[i] = *(const LAS f32x4*)(kS + (tx + 16 * i) * 132 + d); }
#pragma unroll
            for (int i = 0; i < 4; ++i)
#pragma unroll
                for (int j = 0; j < 4; ++j) acc[i][j] += (av[i][0] * bv[j][0] + av[i][1] * bv[j][1]) + (av[i][2] * bv[j][2] + av[i][3] * bv[j][3]);
        }
#pragma unroll
        for (int i = 0; i < 4; ++i)
#pragma unroll
            for (int j = 0; j < 4; ++j) { const int ii = ty + 16 * i, jj = tx + 16 * j;
                const float dec = (ii >= jj) ? __expf(gcS[ii] - gcS[jj]) : 0.f;
                if (half == 0) Ls[ii * 68 + jj] = (ii > jj) ? betaS[ii] * acc[i][j] * dec : 0.f;
                else { const unsigned w = pk2(acc[i][j] * dec, 0.f); qk_o[ii * 64 + jj] = (bf16_t)(w & 0xffffu); } }
    }
    __syncthreads();
    if (tid < 256) {
        const int c = tid;
        unsigned msb = (c < 128) ? (unsigned)(CP_V + 4 * c) : (unsigned)(CP_K + 4 * (c - 128)), sclb = (c < 128) ? (unsigned)CP_MISC : (unsigned)(CP_MISC + 512), lsb = CP_L;
        asm volatile("" : "+v"(msb), "+v"(sclb), "+v"(lsb));
        const LAS float* Msrc = (const LAS float*)(lds + msb);
        const LAS float* scl = (const LAS float*)(lds + sclb);
        const LAS float* Lsr = (const LAS float*)(lds + lsb);
        float sol[64];
#pragma unroll
        for (int i = 0; i < 64; ++i) {
            float a = Msrc[i * 132] * scl[i];
#pragma unroll
            for (int j4 = 0; j4 < i; j4 += 4) {
                const f32x4 l = *(const LAS f32x4*)(Lsr + i * 68 + j4);
                a -= l[0] * sol[j4];
                if (j4 + 1 < i) a -= l[1] * sol[j4 + 1];
                if (j4 + 2 < i) a -= l[2] * sol[j4 + 2];
                if (j4 + 3 < i) a -= l[3] * sol[j4 + 3];
            }
            sol[i] = a;
            if (c < 128) value_o[i * 128 + c] = a;
            else { const unsigned w = pk2(-a, 0.f); kcum_o[i * 128 + (c - 128)] = (bf16_t)(w & 0xffffu); }
        }
    } else {
        const int t = tid - 256;
        for (int it = t; it < 1024; it += 256) { const int i = it >> 4, c = (it & 15) * 8; const float e = egS[i];
            const f32x4 a = *(const LAS f32x4*)(qS + i * 132 + c) * e, bq = *(const LAS f32x4*)(qS + i * 132 + c + 4) * e;
            u32x4 w; w.x = pk2(a[0], a[1]); w.y = pk2(a[2], a[3]); w.z = pk2(bq[0], bq[1]); w.w = pk2(bq[2], bq[3]);
            *(u32x4*)(qg_o + i * 128 + c) = w; }
        for (int it = t; it < 1024; it += 256) { const int d = it & 127, i0 = (it >> 7) * 8; float v[8];
#pragma unroll
            for (int e = 0; e < 8; ++e) v[e] = kS[(i0 + e) * 132 + d] * etS[i0 + e];
            u32x4 w; w.x = pk2(v[0], v[1]); w.y = pk2(v[2], v[3]); w.z = pk2(v[4], v[5]); w.w = pk2(v[6], v[7]);
            *(u32x4*)(ktT_o + d * 64 + i0) = w; }
    }
    __syncthreads();
}
__device__ __forceinline__ void pool_diff(const Params& p) {
    unsigned char* ws = p.ws;
    const bf16_t* proj = (const bf16_t*)(ws + OFF_PROJ); bf16_t* dp = (bf16_t*)(ws + OFF_DPOOL);
    for (int it = blockIdx.x * 512 + threadIdx.x; it < MTOK * 128; it += gridDim.x * 512) {
        const int t = it >> 7, c = (it & 127) * 8, g = c >> 8, w = 2 << g, tl = t & (SEQ - 1);
        const int cnt = (tl + 1 < w) ? tl + 1 : w;
        const bf16_t* src = proj + (size_t)t * NPROJ + 4096 + c;
        float s[8], u0[8];
        { const u32x4 raw = *(const u32x4*)src; u0[0] = bflo(raw.x); u0[1] = bfhi(raw.x); u0[2] = bflo(raw.y); u0[3] = bfhi(raw.y); u0[4] = bflo(raw.z); u0[5] = bfhi(raw.z); u0[6] = bflo(raw.w); u0[7] = bfhi(raw.w); }
#pragma unroll
        for (int e = 0; e < 8; ++e) s[e] = u0[e];
        for (int j = 1; j < cnt; ++j) { const u32x4 raw = *(const u32x4*)(src - (size_t)j * NPROJ);
            s[0] += bflo(raw.x); s[1] += bfhi(raw.x); s[2] += bflo(raw.y); s[3] += bfhi(raw.y); s[4] += bflo(raw.z); s[5] += bfhi(raw.z); s[6] += bflo(raw.w); s[7] += bfhi(raw.w); }
        const float inv = 1.0f / (float)cnt;
        u32x4 o; o.x = pk2(s[0] * inv - u0[0], s[1] * inv - u0[1]); o.y = pk2(s[2] * inv - u0[2], s[3] * inv - u0[3]); o.z = pk2(s[4] * inv - u0[4], s[5] * inv - u0[5]); o.w = pk2(s[6] * inv - u0[6], s[7] * inv - u0[7]);
        *(u32x4*)(dp + (size_t)t * 1024 + c) = o;
    }
}

constexpr int SC_KC = 0, SC_QG = 16896, SC_KT = 33792, SC_QK = 51200, SC_OT = 59904;
__device__ __forceinline__ bf16x8 packh(const f32x16& x, int s) {
    u32x4 r; r.x = pk2(x[8 * s + 0], x[8 * s + 1]); r.y = pk2(x[8 * s + 2], x[8 * s + 3]); r.z = pk2(x[8 * s + 4], x[8 * s + 5]); r.w = pk2(x[8 * s + 6], x[8 * s + 7]);
    return __builtin_bit_cast(bf16x8, r);
}
__device__ __forceinline__ bf16x8 frag_rd(const LAS unsigned char* base, int byteoff) {
    const u32x2 lo = *(const LAS u32x2*)(base + byteoff), hi = *(const LAS u32x2*)(base + byteoff + 16);
    u32x4 r; r.x = lo.x; r.y = lo.y; r.z = hi.x; r.w = hi.y; return __builtin_bit_cast(bf16x8, r);
}
__device__ __forceinline__ void scan_phase(const Params& p, LAS unsigned char* lds, int bh) {
    const int tid = threadIdx.x, lane = tid & 63, wave = __builtin_amdgcn_readfirstlane(tid >> 6);
    const int b = bh >> 3, h = bh & 7;
    unsigned char* ws = p.ws;
    const bf16_t* proj = (const bf16_t*)(ws + OFF_PROJ); bf16_t* mix = (bf16_t*)(ws + OFF_MIX);
    const float* glast = (const float*)(ws + OFF_GLAST);
    const int r = lane & 31, hh = lane >> 5;
    f32x16 S[4]; bf16x8 Sb[8];
#pragma unroll
    for (int i = 0; i < 4; ++i)
#pragma unroll
        for (int e = 0; e < 16; ++e) S[i][e] = 0.f;
#pragma unroll
    for (int i = 0; i < 8; ++i) Sb[i] = (bf16x8){0, 0, 0, 0, 0, 0, 0, 0};
    const int frow = tid >> 3, fpart = tid & 7;
    float onw[16];
#pragma unroll
    for (int e = 0; e < 16; ++e) onw[e] = p.in[I_ONW][16 * fpart + e];
    LAS float* oT = (LAS float*)(lds + SC_OT);
    for (int n = 0; n < NCH; ++n) {
        const int item = bh * 32 + n, t0 = b * SEQ + n * CH;
        const unsigned char* cb = ws + OFF_CHUNK + (size_t)item * CHUNK_BYTES;
        for (int it = tid; it < 3584; it += 512) {
            int q = it; const unsigned char* src; int dst;
            if (q < 1024) { src = cb + 32768 + q * 16; dst = SC_KC + (q >> 4) * 264 + (q & 15) * 16; }
            else if (q < 2048) { q -= 1024; src = cb + 49152 + q * 16; dst = SC_QG + (q >> 4) * 264 + (q & 15) * 16; }
            else if (q < 3072) { q -= 2048; src = cb + 65536 + q * 16; dst = SC_KT + (q >> 3) * 136 + (q & 7) * 16; }
            else { q -= 3072; src = cb + 81920 + q * 16; dst = SC_QK + (q >> 3) * 136 + (q & 7) * 16; }
            const u32x4 v = *(const u32x4*)src;
            *(LAS u32x2*)(lds + dst) = (u32x2){v.x, v.y}; *(LAS u32x2*)(lds + dst + 8) = (u32x2){v.z, v.w};
        }
        f32x16 vn[2];
        if (wave < 4) {
            const float* val = (const float*)cb;
#pragma unroll
            for (int mi = 0; mi < 2; ++mi)
#pragma unroll
                for (int i = 0; i < 16; ++i) vn[mi][i] = val[(32 * mi + (i & 3) + 8 * (i >> 2) + 4 * hh) * 128 + 32 * wave + r];
        }
        __syncthreads();
        if (wave < 4) {
            const float gl = glast[item];
            f32x16 o[2];
#pragma unroll
            for (int mi = 0; mi < 2; ++mi) {
#pragma unroll
                for (int e = 0; e < 16; ++e) o[mi][e] = 0.f;
#pragma unroll
                for (int ks = 0; ks < 8; ++ks) {
                    const int off = (32 * mi + r) * 264 + (16 * ks + 4 * hh) * 2;
                    vn[mi] = __builtin_amdgcn_mfma_f32_32x32x16_bf16(frag_rd(lds + SC_KC, off), Sb[ks], vn[mi], 0, 0, 0);
                    o[mi] = __builtin_amdgcn_mfma_f32_32x32x16_bf16(frag_rd(lds + SC_QG, off), Sb[ks], o[mi], 0, 0, 0);
                }
            }
            bf16x8 vb[4];
#pragma unroll
            for (int ks = 0; ks < 4; ++ks) vb[ks] = packh(vn[ks >> 1], ks & 1);
#pragma unroll
            for (int mi = 0; mi < 2; ++mi)
#pragma unroll
                for (int ks = 0; ks < 4; ++ks)
                    o[mi] = __builtin_amdgcn_mfma_f32_32x32x16_bf16(frag_rd(lds + SC_QK, (32 * mi + r) * 136 + (16 * ks + 4 * hh) * 2), vb[ks], o[mi], 0, 0, 0);
#pragma unroll
            for (int mt = 0; mt < 4; ++mt) {
                S[mt] = S[mt] * gl;
#pragma unroll
                for (int ks = 0; ks < 4; ++ks)
                    S[mt] = __builtin_amdgcn_mfma_f32_32x32x16_bf16(frag_rd(lds + SC_KT, (32 * mt + r) * 136 + (16 * ks + 4 * hh) * 2), vb[ks], S[mt], 0, 0, 0);
                Sb[2 * mt] = packh(S[mt], 0); Sb[2 * mt + 1] = packh(S[mt], 1);
            }
#pragma unroll
            for (int mi = 0; mi < 2; ++mi)
#pragma unroll
                for (int i = 0; i < 16; ++i) oT[(32 * mi + (i & 3) + 8 * (i >> 2) + 4 * hh) * 132 + 32 * wave + r] = o[mi][i];
        }
        __syncthreads();
        {
            f32x4 v[4]; float ss = 0.f;
#pragma unroll
            for (int e = 0; e < 4; ++e) { v[e] = *(const LAS f32x4*)(oT + frow * 132 + 16 * fpart + 4 * e); ss += (v[e][0] * v[e][0] + v[e][1] * v[e][1]) + (v[e][2] * v[e][2] + v[e][3] * v[e][3]); }
            ss += __shfl_xor(ss, 1); ss += __shfl_xor(ss, 2); ss += __shfl_xor(ss, 4);
            const float rs = rsqrtf(ss * (1.0f / HD) + EPS);
            const bf16_t* zp = proj + (size_t)(t0 + frow) * NPROJ + 3072 + h * HD + 16 * fpart;
            const u32x4 z0 = *(const u32x4*)zp, z1 = *(const u32x4*)(zp + 8);
            float zf[16] = {bflo(z0.x), bfhi(z0.x), bflo(z0.y), bfhi(z0.y), bflo(z0.z), bfhi(z0.z), bflo(z0.w), bfhi(z0.w), bflo(z1.x), bfhi(z1.x), bflo(z1.y), bfhi(z1.y), bflo(z1.z), bfhi(z1.z), bflo(z1.w), bfhi(z1.w)};
            float ov[16];
#pragma unroll
            for (int e = 0; e < 16; ++e) ov[e] = v[e >> 2][e & 3] * rs * onw[e] * silu_f(zf[e]);
            u32x4 w0, w1; w0.x = pk2(ov[0], ov[1]); w0.y = pk2(ov[2], ov[3]); w0.z = pk2(ov[4], ov[5]); w0.w = pk2(ov[6], ov[7]);
            w1.x = pk2(ov[8], ov[9]); w1.y = pk2(ov[10], ov[11]); w1.z = pk2(ov[12], ov[13]); w1.w = pk2(ov[14], ov[15]);
            bf16_t* mp = mix + (size_t)(t0 + frow) * DM + h * HD + 16 * fpart;
            *(u32x4*)mp = w0; *(u32x4*)(mp + 8) = w1;
        }
    }
    __syncthreads();
}

__device__ __forceinline__ void act_phase(const Params& p) {
    unsigned char* ws = p.ws;
    const bf16_t* up = (const bf16_t*)(ws + OFF_UP); bf16_t* act = (bf16_t*)(ws + OFF_ACT);
    const float* cw = p.in[I_CONVF]; const float* cbias = p.in[I_CONVFB];
    constexpr int NCG = DFF / 8, RB = 32;
    for (int it = blockIdx.x * 512 + threadIdx.x; it < (MTOK / RB) * NCG; it += gridDim.x * 512) {
        const int cgp = it % NCG, rb = it / NCG, c = cgp * 8, t0 = rb * RB;
        float wg[3][8], wv[3][8], bg[8], bv[8];
#pragma unroll
        for (int j = 0; j < 3; ++j)
#pragma unroll
            for (int e = 0; e < 8; ++e) { wg[j][e] = cw[j * NUP + c + e]; wv[j][e] = cw[j * NUP + DFF + c + e]; }
#pragma unroll
        for (int e = 0; e < 8; ++e) { bg[e] = cbias[c + e]; bv[e] = cbias[DFF + c + e]; }
        float g2[8], g1[8], v2[8], v1[8];
        const bool first = ((t0 & (SEQ - 1)) == 0);
#pragma unroll
        for (int e = 0; e < 8; ++e) { g2[e] = 0.f; g1[e] = 0.f; v2[e] = 0.f; v1[e] = 0.f; }
        if (!first) {
            const u32x4 a = *(const u32x4*)(up + (size_t)(t0 - 2) * NUP + c), b2 = *(const u32x4*)(up + (size_t)(t0 - 1) * NUP + c);
            const u32x4 cc = *(const u32x4*)(up + (size_t)(t0 - 2) * NUP + DFF + c), d = *(const u32x4*)(up + (size_t)(t0 - 1) * NUP + DFF + c);
            g2[0] = bflo(a.x); g2[1] = bfhi(a.x); g2[2] = bflo(a.y); g2[3] = bfhi(a.y); g2[4] = bflo(a.z); g2[5] = bfhi(a.z); g2[6] = bflo(a.w); g2[7] = bfhi(a.w);
            g1[0] = bflo(b2.x); g1[1] = bfhi(b2.x); g1[2] = bflo(b2.y); g1[3] = bfhi(b2.y); g1[4] = bflo(b2.z); g1[5] = bfhi(b2.z); g1[6] = bflo(b2.w); g1[7] = bfhi(b2.w);
            v2[0] = bflo(cc.x); v2[1] = bfhi(cc.x); v2[2] = bflo(cc.y); v2[3] = bfhi(cc.y); v2[4] = bflo(cc.z); v2[5] = bfhi(cc.z); v2[6] = bflo(cc.w); v2[7] = bfhi(cc.w);
            v1[0] = bflo(d.x); v1[1] = bfhi(d.x); v1[2] = bflo(d.y); v1[3] = bfhi(d.y); v1[4] = bflo(d.z); v1[5] = bfhi(d.z); v1[6] = bflo(d.w); v1[7] = bfhi(d.w);
        }
#pragma unroll 4
        for (int rr = 0; rr < RB; ++rr) {
            const int t = t0 + rr;
            const u32x4 a = *(const u32x4*)(up + (size_t)t * NUP + c), d = *(const u32x4*)(up + (size_t)t * NUP + DFF + c);
            float g0[8] = {bflo(a.x), bfhi(a.x), bflo(a.y), bfhi(a.y), bflo(a.z), bfhi(a.z), bflo(a.w), bfhi(a.w)};
            float v0[8] = {bflo(d.x), bfhi(d.x), bflo(d.y), bfhi(d.y), bflo(d.z), bfhi(d.z), bflo(d.w), bfhi(d.w)};
            float o[8];
#pragma unroll
            for (int e = 0; e < 8; ++e) {
                const float G = wg[0][e] * g2[e] + wg[1][e] * g1[e] + wg[2][e] * g0[e] + bg[e];
                const float V = wv[0][e] * v2[e] + wv[1][e] * v1[e] + wv[2][e] * v0[e] + bv[e];
                o[e] = silu_f(G) * V; g2[e] = g1[e]; g1[e] = g0[e]; v2[e] = v1[e]; v1[e] = v0[e];
            }
            u32x4 w; w.x = pk2(o[0], o[1]); w.y = pk2(o[2], o[3]); w.z = pk2(o[4], o[5]); w.w = pk2(o[6], o[7]);
            *(u32x4*)(act + (size_t)t * DFF + c) = w;
        }
    }
}
__device__ __forceinline__ void final_phase(const Params& p) {
    const float* ssq3 = (const float*)(p.ws + OFF_SSQ3); const float* fw = p.in[I_FNW];
    f32x4* o = (f32x4*)p.out;
    for (int i = blockIdx.x * 512 + threadIdx.x; i < MTOK * DM / 4; i += gridDim.x * 512) {
        const int row = i >> 9, c4 = i & 511;
        const float rs = rsqrtf(ssq3[row] * (1.0f / DM) + EPS);
        const f32x4 w = *(const f32x4*)(fw + 4 * c4);
        o[i] = o[i] * rs * w;
    }
}

constexpr int NPHASE = 9;
template <bool COOP>
__global__ void __launch_bounds__(512, 2) mk_fwd(Params p) {
    extern __shared__ __attribute__((aligned(16))) unsigned char lds_raw[];
    LAS unsigned char* lds = (LAS unsigned char*)lds_raw;
    unsigned char* ws = p.ws;
    const int lo = p.ph_lo, hi = p.ph_hi;
    const int G = gridDim.x, bid = blockIdx.x;
#define IN(k) (lo <= (k) && (k) < hi)
#define SEAM(k) do { if (COOP) { if ((k) + 1 < hi) xcd_barrier(bar); } } while (0)
    XcdBarrier bar; bar.bar = (unsigned*)(ws + OFF_BAR); bar.x = 0; bar.st = (volatile LAS unsigned*)(lds + LDS_MISC);
    if (COOP) {
        if (hi > 1000) cg::this_grid().sync();
        if (threadIdx.x < 4) ((LAS unsigned*)(lds + LDS_MISC))[threadIdx.x] = 0u;
        __syncthreads();
        bar = xcd_barrier_post((unsigned*)(ws + OFF_BAR), (volatile LAS unsigned*)(lds + LDS_MISC));
    }
    if (IN(0)) { phase_prep(p, lds); SEAM(0); }
    if (IN(1)) {
        pg8::Gemm g{(const bf16_t*)(ws + OFF_XB), (const bf16_t*)(ws + OFF_WIN), MTOK, N1, DM, DM, DM, 0};
        pg8::StaticOrder S; S.init(MTOK, N1, G, bid);
        EpiProj E{(bf16_t*)(ws + OFF_PROJ), (float*)(ws + OFF_LOGIT), (const float*)(ws + OFF_RSTD1)};
        pg8::gemm_phase<EpiProj>(lds, g, S, E);
        SEAM(1);
    }
    if (IN(2)) {
        for (int item = bid; item < 1024; item += G) chunk_prep(p, lds, item);
        pool_diff(p);
        SEAM(2);
    }
    if (IN(3)) {
        if (bid < 32) scan_phase(p, lds, bid);
        else {
            pg8::Gemm g{(const bf16_t*)(ws + OFF_DPOOL), (const bf16_t*)(ws + OFF_POOLT), MTOK, 1024, 256, 1024, 256, 512};
            pg8::StaticOrder S; S.init(MTOK, 1024, G - 32, bid - 32);
            EpiBf E{(bf16_t*)(ws + OFF_MIX), DM, 1024, nullptr};
            pg8::gemm_phase<EpiBf>(lds, g, S, E);
            phase_prep2(p, lds, (bid - 32) * 8 + (int)(threadIdx.x >> 6), (G - 32) * 8);
        }
        SEAM(3);
    }
    if (IN(4)) {
        pg8::Gemm g{(const bf16_t*)(ws + OFF_MIX), (const bf16_t*)(ws + OFF_WOUT), MTOK, DM, DM, DM, DM, 0};
        pg8::StaticOrder S; S.init(MTOK, DM, G, bid);
        EpiRes E{p.in[I_X], p.out, (bf16_t*)(ws + OFF_XB), (float*)(ws + OFF_SSQ2)};
        pg8::gemm_phase<EpiRes>(lds, g, S, E);
        SEAM(4);
    }
    if (IN(5)) {
        pg8::Gemm g{(const bf16_t*)(ws + OFF_XB), (const bf16_t*)(ws + OFF_WUP), MTOK, NUP, DM, DM, DM, 0};
        pg8::StaticOrder S; S.init(MTOK, NUP, G, bid);
        EpiBf E{(bf16_t*)(ws + OFF_UP), NUP, 0, (const float*)(ws + OFF_SSQ2)};
        pg8::gemm_phase<EpiBf>(lds, g, S, E);
        SEAM(5);
    }
    if (IN(6)) { act_phase(p); SEAM(6); }
    if (IN(7)) {
        pg8::Gemm g{(const bf16_t*)(ws + OFF_ACT), (const bf16_t*)(ws + OFF_WDOWN), MTOK, DM, DFF, DFF, DFF, 0};
        pg8::StaticOrder S; S.init(MTOK, DM, G, bid);
        EpiRes E{p.out, p.out, nullptr, (float*)(ws + OFF_SSQ3)};
        pg8::gemm_phase<EpiRes>(lds, g, S, E);
        SEAM(7);
    }
    if (IN(8)) { final_phase(p); }
#undef IN
#undef SEAM
}

extern "C" void kernel_launch(void* const* d_in, const int* in_sizes, int n_in, void* d_out, int out_size, void* d_ws, size_t ws_size, hipStream_t stream) {
    static int grid = 0;
    if (!grid) {
        if (n_in != 16 || out_size != MTOK * DM || ws_size < WS_END) { fprintf(stderr, "kernel_launch: unexpected shapes (n_in %d out %d ws %zu, need %zu)\n", n_in, out_size, ws_size, (size_t)WS_END); grid = -1; return; }
        int dev = 0, cus = 0, per_cu = 0;
        hipGetDevice(&dev); hipDeviceGetAttribute(&cus, hipDeviceAttributeMultiprocessorCount, dev);
#if ONE_LAUNCH
        hipFuncSetAttribute((const void*)mk_fwd<true>, hipFuncAttributeMaxDynamicSharedMemorySize, LDS_BYTES);
        hipOccupancyMaxActiveBlocksPerMultiprocessor(&per_cu, mk_fwd<true>, 512, LDS_BYTES);
#else
        hipFuncSetAttribute((const void*)mk_fwd<false>, hipFuncAttributeMaxDynamicSharedMemorySize, LDS_BYTES);
        hipOccupancyMaxActiveBlocksPerMultiprocessor(&per_cu, mk_fwd<false>, 512, LDS_BYTES);
#endif
        if (per_cu < 1) per_cu = 1;
        grid = cus * per_cu;
        if (grid < 64) { fprintf(stderr, "kernel_launch: grid %d too small\n", grid); grid = -1; return; }
    }
    if (grid < 0) return;
    Params p{};
    for (int i = 0; i < 16; ++i) p.in[i] = (const float*)d_in[i];
    p.out = (float*)d_out; p.ws = (unsigned char*)d_ws;
#if ONE_LAUNCH
    p.ph_lo = 0; p.ph_hi = NPHASE;
    void* args[] = {&p};
    if (hipMemsetAsync((unsigned char*)d_ws + OFF_BAR, 0, XCD_BAR_WORDS * 4, stream) != hipSuccess) { fprintf(stderr, "kernel_launch: memset failed\n"); return; }
    hipError_t e = hipLaunchCooperativeKernel((const void*)mk_fwd<true>, dim3(grid), dim3(512), args, LDS_BYTES, stream);
    if (e != hipSuccess) fprintf(stderr, "cooperative launch failed: %s (grid %d)\n", hipGetErrorString(e), grid);
#else
    static const int plist[] = {PLIST};
    for (int ph : plist) { p.ph_lo = ph; p.ph_hi = ph + 1; hipLaunchKernelGGL(mk_fwd<false>, dim3(grid), dim3(512), LDS_BYTES, stream, p); }
#endif
}
```

```cpp
#include <hip/hip_runtime.h>
#include <hip/hip_cooperative_groups.h>
#include <cstdio>
#include <cstdint>
namespace cg = cooperative_groups;

#ifndef ONE_LAUNCH
#define ONE_LAUNCH 1
#endif

#ifndef PLIST
#define PLIST 0,1,2,3,4,5,6,7,8
#endif
#define LAS __attribute__((address_space(3)))
typedef unsigned short bf16_t;
typedef short bf16x8 __attribute__((ext_vector_type(8)));
typedef float f32x4 __attribute__((ext_vector_type(4)));
typedef float f32x2 __attribute__((ext_vector_type(2)));
typedef float f32x16 __attribute__((ext_vector_type(16)));
typedef unsigned u32x4 __attribute__((ext_vector_type(4)));
typedef unsigned u32x2 __attribute__((ext_vector_type(2)));
typedef __bf16 bf16x2_t __attribute__((ext_vector_type(2)));

__device__ __forceinline__ unsigned pk2(float lo, float hi) { f32x2 v = {lo, hi}; bf16x2_t r = __builtin_convertvector(v, bf16x2_t); return __builtin_bit_cast(unsigned, r); }
__device__ __forceinline__ float bflo(unsigned w) { return __uint_as_float(w << 16); }
__device__ __forceinline__ float bfhi(unsigned w) { return __uint_as_float(w & 0xffff0000u); }
__device__ __forceinline__ float silu_f(float x) { return x / (1.0f + __expf(-x)); }

constexpr int SEQ = 2048, DM = 2048, MTOK = 8192;
constexpr int NH = 8, HD = 128, CH = 64, NCH = SEQ / CH;
constexpr int DFF = 5632, NUP = 2 * DFF;
constexpr int INW = 5136, NPROJ = 5120, N1 = 5376;
constexpr float EPS = 1e-6f;

constexpr size_t OFF_WIN = 0;
constexpr size_t OFF_WOUT = OFF_WIN + (size_t)N1 * DM * 2;
constexpr size_t OFF_WUP = OFF_WOUT + (size_t)DM * DM * 2;
constexpr size_t OFF_XB = OFF_WUP + (size_t)NUP * DM * 2;
constexpr size_t OFF_ACT = 0;
constexpr size_t OFF_WDOWN = OFF_XB + (size_t)MTOK * DM * 2;
constexpr size_t OFF_POOLT = OFF_WDOWN + (size_t)DM * DFF * 2;
constexpr size_t OFF_LOGIT = OFF_POOLT + 4 * 256 * 256 * 2;
constexpr size_t OFF_RSTD1 = OFF_LOGIT + (size_t)MTOK * 16 * 4;
constexpr size_t OFF_SSQ2 = OFF_RSTD1 + MTOK * 4;
constexpr size_t OFF_SSQ3 = OFF_SSQ2 + MTOK * 4;
constexpr size_t OFF_GLAST = OFF_SSQ3 + MTOK * 4;
constexpr size_t OFF_BAR = OFF_GLAST + 4096;
constexpr size_t OFF_B = ((OFF_BAR + 16384 + 1048575) / 1048576) * 1048576;
constexpr size_t OFF_UP = OFF_B;
constexpr size_t OFF_PROJ = OFF_B;
constexpr size_t CHUNK_BYTES = 32768 + 16384 * 3 + 8192;
constexpr size_t OFF_CHUNK = OFF_PROJ + (size_t)MTOK * NPROJ * 2;
constexpr size_t OFF_DPOOL = OFF_CHUNK + 1024 * CHUNK_BYTES;
constexpr size_t OFF_MIX = OFF_DPOOL + (size_t)MTOK * 1024 * 2;
constexpr size_t WS_END = OFF_MIX + (size_t)MTOK * DM * 2;
static_assert(OFF_ACT + (size_t)MTOK * DFF * 2 <= OFF_WDOWN, "act overlay");
static_assert(OFF_UP + (size_t)MTOK * NUP * 2 <= WS_END, "up overlay");

constexpr int LDS_BYTES = 147456, LDS_MISC = 147200;
static_assert(WS_END <= 369098752, "workspace budget");


#define XB_TMO      128
#define XB_XCNT(j)  (256  + 64 * (j))
#define XB_XSUB(j)  (1280 + 64 * (j))
#define XB_XGEN(j)  (2304 + 64 * (j))
#define XB_TOP      3328
#define XB_TOPGEN   3392
#define XCD_BAR_WORDS 3456
#define XB_SPIN_CAP (1u << 18)
__device__ __forceinline__ unsigned xb_ld(unsigned* p)              { return __hip_atomic_load(p, __ATOMIC_RELAXED, __HIP_MEMORY_SCOPE_AGENT); }
__device__ __forceinline__ unsigned xb_add(unsigned* p, unsigned v) { return __hip_atomic_fetch_add(p, v, __ATOMIC_RELAXED, __HIP_MEMORY_SCOPE_AGENT); }
__device__ __forceinline__ unsigned xb_xcc_id() { return (unsigned)__builtin_amdgcn_s_getreg((3 << 11) | 20) & 0xFu; }
#define XB_SPIN(cond, bar) do { unsigned _sp = 0; while (cond) { __builtin_amdgcn_s_sleep(1); \
    if ((++_sp & 255u) == 0u) { if (xb_ld(&(bar)[XB_TMO])) break; if (_sp > XB_SPIN_CAP) { atomicAdd(&(bar)[XB_TMO], 1u); break; } } } } while (0)
struct XcdBarrier { unsigned* bar; unsigned x; volatile LAS unsigned* st; };
__device__ __forceinline__ XcdBarrier xcd_barrier_post(unsigned* bar, volatile LAS unsigned* st) {
    XcdBarrier b; b.bar = bar; b.x = xb_xcc_id(); b.st = st;
    if (threadIdx.x == 0) (void)xb_add(&bar[XB_XCNT(b.x)], 1u);
    return b;
}
__device__ __forceinline__ void xcd_barrier_complete(unsigned* bar, unsigned x, unsigned& nloc, unsigned& nx) {
    const unsigned G = gridDim.x * gridDim.y * gridDim.z;
    unsigned sum, cnt, mine, sp = 0u;
    for (;;) {
        sum = 0u; cnt = 0u; mine = 0u;
#pragma unroll
        for (unsigned j = 0; j < 16; ++j) { const unsigned c = xb_ld(&bar[XB_XCNT(j)]); sum += c; cnt += (c > 0u) ? 1u : 0u; mine = (j == x) ? c : mine; }
        if (sum == G) break;
        __builtin_amdgcn_s_sleep(1);
        if ((++sp & 255u) == 0u) { if (xb_ld(&bar[XB_TMO])) break; if (sp > XB_SPIN_CAP) { atomicAdd(&bar[XB_TMO], 1u); break; } }
    }
    nloc = mine > 0u ? mine : 1u; nx = cnt > 0u ? cnt : 1u;
}
__device__ __forceinline__ void xcd_barrier(const XcdBarrier& b) {
    asm volatile("s_waitcnt vmcnt(0)" ::: "memory");
    __syncthreads();
    if (threadIdx.x == 0) {
        unsigned* bar = b.bar;
        __builtin_amdgcn_s_waitcnt(0);
        unsigned nloc = b.st[0], nx = b.st[1];
        if (nloc == 0u) { xcd_barrier_complete(bar, b.x, nloc, nx); b.st[0] = nloc; b.st[1] = nx; }
        const unsigned old = xb_add(&bar[XB_XSUB(b.x)], 1u);
        const unsigned gen = old / nloc;
        if (old + 1u == (gen + 1u) * nloc) {
            __builtin_amdgcn_fence(__ATOMIC_RELEASE, "agent");
            asm volatile("s_waitcnt vmcnt(0)" ::: "memory");
            const unsigned og = xb_add(&bar[XB_TOP], 1u);
            const unsigned tg = og / nx;
            if (og + 1u == (tg + 1u) * nx) xb_add(&bar[XB_TOPGEN], 1u);
            else XB_SPIN(xb_ld(&bar[XB_TOPGEN]) == tg, bar);
            __builtin_amdgcn_fence(__ATOMIC_ACQUIRE, "agent");
            xb_add(&bar[XB_XGEN(b.x)], 1u);
            asm volatile("s_waitcnt vmcnt(0)" ::: "memory");
        } else {
            XB_SPIN(xb_ld(&bar[XB_XGEN(b.x)]) == gen, bar);
            __builtin_amdgcn_fence(__ATOMIC_ACQUIRE, "agent");
            asm volatile("s_waitcnt vmcnt(0)" ::: "memory");
        }
    }
    __syncthreads();
}

namespace pg8 {
constexpr int BM = 256, BK = 64, HALF = 128, HTB = HALF * BK * 2, NXCD = 8, WGM = 8;
__host__ __device__ __forceinline__ int lds_byte(int r, int c) { const int st = (r >> 4) * 2 + (c >> 5), rr = r & 15, cc = c & 31, ob = rr * 64 + cc * 2; return st * 1024 + (ob ^ (((ob >> 9) & 1) << 5)); }
__host__ __device__ __forceinline__ void stage_rc(int b, int& R, int& C) { const int st = b / 1024, sb = b % 1024, swz = sb ^ (((sb >> 9) & 1) << 5); R = (st >> 1) * 16 + swz / 64; C = (st & 1) * 32 + (swz % 64) / 2; }
__host__ __device__ __forceinline__ int perm32(int rho) { const int n = rho >> 4, i = rho & 15; return 8 * (i >> 2) + 4 * n + (i & 3); }

struct Unit { int pm, pn; };
struct Gemm { const bf16_t* A; const bf16_t* Bt; int M, N, K, lda, ldb, a_pn_off; };

struct StaticOrder {
    int nM, nN, nwg, G, c;
    __host__ __device__ void init(int M, int N, int G_, int c_) { nM = M / BM; nN = N / BM; nwg = nM * nN; G = G_; c = c_; }
    __host__ __device__ bool next(int i, Unit& u) const {
        if (c < 0) return false;
        const long L = (long)i * G + c; if (L >= nwg) return false;
        int wgid = (int)L; { const int q = nwg / NXCD, r = nwg % NXCD, xcd = wgid % NXCD, off = wgid / NXCD; wgid = (xcd < r ? xcd * (q + 1) : r * (q + 1) + (xcd - r) * q) + off; }
        const int nig = WGM * nN, gid = wgid / nig, fm = gid * WGM, gsz = (nM - fm) < WGM ? (nM - fm) : WGM;
        u.pm = fm + ((wgid % nig) % gsz); u.pn = (wgid % nig) / gsz; return true;
    }
};

template <class Epi>
__device__ __forceinline__ void gemm_phase(LAS unsigned char* lds, const Gemm g, const StaticOrder& S, const Epi& E) {
    const int tid = threadIdx.x, wid = __builtin_amdgcn_readfirstlane(tid >> 6), lane = tid & 63, wr = wid >> 2, wc = wid & 3, fr = lane & 15, fq = lane >> 4;
    const int K = g.K, nt = K / BK;
    unsigned voffA[2], voffB[2];
#pragma unroll
    for (int i = 0; i < 2; ++i) { int R, C; stage_rc(tid * 16 + i * 8192, R, C); const int Rb = Epi::PERM ? ((R & ~31) + perm32(R & 31)) : R;
        voffA[i] = (unsigned)(R * g.lda + C) * 2u; voffB[i] = (unsigned)(Rb * g.ldb + C) * 2u; }
    const size_t kstep = (size_t)(BK * 2);
    const size_t hstepA = (size_t)HALF * g.lda * 2, hstepB = (size_t)HALF * g.ldb * 2;
    const size_t tstepA = 2 * hstepA, tstepB = 2 * hstepB;
    const unsigned ldsw = (unsigned)wid * 1024u;
    const int aoff = lds_byte(wr * 64 + fr, fq * 8), boff = lds_byte(wc * 32 + fr, fq * 8);
#define PG8_SA(b, h) (((b) * 2 + (h)) * HTB)
#define PG8_SB(b, h) ((4 + (b) * 2 + (h)) * HTB)
#define PG8_STAGE(bufoff, gbase, voff) do { _Pragma("unroll") for (int _i = 0; _i < 2; ++_i) \
        __builtin_amdgcn_global_load_lds((const unsigned*)((const char*)(gbase) + (voff)[_i]), (LAS unsigned*)(lds + (bufoff) + ldsw + _i * 8192), 16, 0, 0); } while (0)
#define PG8_LDA(dst, b, h) do { _Pragma("unroll") for (int m = 0; m < 4; ++m) _Pragma("unroll") for (int k = 0; k < 2; ++k) dst[m][k] = *(const LAS bf16x8*)(lds + PG8_SA(b, h) + aoff + m * 2048 + k * 1024); } while (0)
#define PG8_LDB(dst, b, h) do { _Pragma("unroll") for (int n = 0; n < 2; ++n) _Pragma("unroll") for (int k = 0; k < 2; ++k) dst[n][k] = *(const LAS bf16x8*)(lds + PG8_SB(b, h) + boff + n * 2048 + k * 1024); } while (0)
#define PG8_MMA(ai, bj, At, Bt) do { __builtin_amdgcn_s_setprio(1); _Pragma("unroll") for (int m = 0; m < 4; ++m) _Pragma("unroll") for (int n = 0; n < 2; ++n) _Pragma("unroll") for (int k = 0; k < 2; ++k) \
        acc[ai][bj][m][n] = __builtin_amdgcn_mfma_f32_16x16x32_bf16(Bt[n][k], At[m][k], acc[ai][bj][m][n], 0, 0, 0); __builtin_amdgcn_s_setprio(0); } while (0)
#define PG8_WAIT_V(n) asm volatile("s_waitcnt vmcnt(" #n ")" ::: "memory")
#define PG8_WAIT_L(n) asm volatile("s_waitcnt lgkmcnt(" #n ")" ::: "memory")
#define PG8_BAR __builtin_amdgcn_s_barrier()
#define PG8_SCHED __builtin_amdgcn_sched_barrier(0)
    Unit cur, nxt; int ui = 0;
    if (!S.next(0, cur)) return;
    f32x4 acc[2][2][4][2];
#pragma unroll
    for (int a = 0; a < 2; ++a)
#pragma unroll
        for (int b = 0; b < 2; ++b)
#pragma unroll
            for (int m = 0; m < 4; ++m)
#pragma unroll
                for (int n = 0; n < 2; ++n) acc[a][b][m][n] = (f32x4){0.f, 0.f, 0.f, 0.f};
    bf16x8 At[4][2], B0[2][2], B1[2][2];
    const char* cA = (const char*)g.A + (size_t)cur.pm * tstepA + (size_t)cur.pn * g.a_pn_off; const char* cB = (const char*)g.Bt + (size_t)cur.pn * tstepB;
    PG8_STAGE(PG8_SB(0, 0), cB, voffB); PG8_STAGE(PG8_SB(0, 1), cB + hstepB, voffB); PG8_STAGE(PG8_SA(0, 0), cA, voffA); PG8_STAGE(PG8_SA(0, 1), cA + hstepA, voffA);
    if (wr == 1) PG8_BAR;
    PG8_WAIT_V(2); PG8_BAR;
    PG8_STAGE(PG8_SB(1, 0), cB + kstep, voffB); PG8_STAGE(PG8_SA(1, 0), cA + kstep, voffA); PG8_STAGE(PG8_SB(1, 1), cB + hstepB + kstep, voffB);
    PG8_WAIT_V(6); PG8_BAR;
    for (;;) {
        const bool has_next = S.next(ui + 1, nxt);
        const char* nA = has_next ? (const char*)g.A + (size_t)nxt.pm * tstepA + (size_t)nxt.pn * g.a_pn_off : cA; const char* nB = has_next ? (const char*)g.Bt + (size_t)nxt.pn * tstepB : cB;
        for (int t = 0; t < nt; t += 2) {
            const bool last = (t == nt - 2);
            const char* a1 = cA + (size_t)(t + 1) * kstep;
            const char* a2 = last ? nA : cA + (size_t)(t + 2) * kstep; const char* b2 = last ? nB : cB + (size_t)(t + 2) * kstep;
            const char* a3 = a2 + kstep; const char* b3 = b2 + kstep;
            PG8_LDB(B0, 0, 0); PG8_LDB(B1, 0, 1); PG8_SCHED; PG8_LDA(At, 0, 0); PG8_STAGE(PG8_SA(1, 1), a1 + hstepA, voffA);
            PG8_WAIT_V(8); PG8_WAIT_L(0); PG8_BAR; PG8_MMA(0, 0, At, B0); PG8_MMA(0, 1, At, B1); PG8_BAR; PG8_SCHED;
            PG8_LDA(At, 0, 1); PG8_STAGE(PG8_SB(0, 0), b2, voffB); PG8_STAGE(PG8_SB(0, 1), b2 + hstepB, voffB); PG8_STAGE(PG8_SA(0, 0), a2, voffA);
            PG8_WAIT_V(8); PG8_WAIT_L(0); PG8_BAR; PG8_MMA(1, 0, At, B0); PG8_MMA(1, 1, At, B1); PG8_BAR; PG8_SCHED;
            PG8_LDB(B0, 1, 0); PG8_LDB(B1, 1, 1); PG8_SCHED; PG8_LDA(At, 1, 0); PG8_STAGE(PG8_SA(0, 1), a2 + hstepA, voffA);
            PG8_WAIT_V(8); PG8_WAIT_L(0); PG8_BAR; PG8_MMA(0, 0, At, B0); PG8_MMA(0, 1, At, B1); PG8_BAR; PG8_SCHED;
            PG8_LDA(At, 1, 1); PG8_STAGE(PG8_SB(1, 0), b3, voffB); PG8_STAGE(PG8_SB(1, 1), b3 + hstepB, voffB); PG8_STAGE(PG8_SA(1, 0), a3, voffA);
            PG8_WAIT_V(8); PG8_WAIT_L(0); PG8_BAR; PG8_MMA(1, 0, At, B0); PG8_MMA(1, 1, At, B1); PG8_BAR; PG8_SCHED;
        }
        if (wr == 0) PG8_BAR;
        E(acc, cur, wr, wc, fr, fq);
        if (!has_next) break;
#pragma unroll
        for (int a = 0; a < 2; ++a)
#pragma unroll
            for (int b = 0; b < 2; ++b)
#pragma unroll
                for (int m = 0; m < 4; ++m)
#pragma unroll
                    for (int n = 0; n < 2; ++n) acc[a][b][m][n] = (f32x4){0.f, 0.f, 0.f, 0.f};
        cur = nxt; cA = nA; cB = nB; ++ui;
        if (wr == 1) PG8_BAR;
    }
    PG8_WAIT_V(0);
    PG8_BAR;
#undef PG8_SA
#undef PG8_SB
#undef PG8_STAGE
#undef PG8_LDA
#undef PG8_LDB
#undef PG8_MMA
#undef PG8_WAIT_V
#undef PG8_WAIT_L
#undef PG8_BAR
#undef PG8_SCHED
}
}

struct EpiProj {
    static constexpr bool PERM = true;
    bf16_t* P; float* logits; const float* rstd;
    __device__ __forceinline__ void operator()(const f32x4 (&acc)[2][2][4][2], const pg8::Unit& u, int wr, int wc, int fr, int fq) const {
        const int row0 = u.pm * 256 + wr * 64 + fr;
        if (u.pn < 20) {
            const int col0 = u.pn * 256 + wc * 32 + 8 * fq;
#pragma unroll
            for (int ai = 0; ai < 2; ++ai)
#pragma unroll
                for (int m = 0; m < 4; ++m) { const int row = row0 + ai * 128 + m * 16; const float rs = rstd[row]; bf16_t* rowp = P + (size_t)row * NPROJ + col0;
#pragma unroll
                    for (int bj = 0; bj < 2; ++bj) { const f32x4 v0 = acc[ai][bj][m][0] * rs, v1 = acc[ai][bj][m][1] * rs;
                        u32x4 w; w.x = pk2(v0[0], v0[1]); w.y = pk2(v0[2], v0[3]); w.z = pk2(v1[0], v1[1]); w.w = pk2(v1[2], v1[3]);
                        *(u32x4*)(rowp + bj * 128) = w; } }
        } else if (wc == 0 && fq < 2) {
#pragma unroll
            for (int ai = 0; ai < 2; ++ai)
#pragma unroll
                for (int m = 0; m < 4; ++m) { const int row = row0 + ai * 128 + m * 16; const float rs = rstd[row]; float* lp = logits + (size_t)row * 16 + 8 * fq;
                    *(f32x4*)lp = acc[ai][0][m][0] * rs; *(f32x4*)(lp + 4) = acc[ai][0][m][1] * rs; }
        }
    }
};
struct EpiBf {
    static constexpr bool PERM = true;
    bf16_t* O; int ldc; int colbase; const float* ssq;
    __device__ __forceinline__ void operator()(const f32x4 (&acc)[2][2][4][2], const pg8::Unit& u, int wr, int wc, int fr, int fq) const {
        const int row0 = u.pm * 256 + wr * 64 + fr; const int col0 = colbase + u.pn * 256 + wc * 32 + 8 * fq;
#pragma unroll
        for (int ai = 0; ai < 2; ++ai)
#pragma unroll
            for (int m = 0; m < 4; ++m) { const int row = row0 + ai * 128 + m * 16; const float rs = ssq ? rsqrtf(ssq[row] * (1.0f / DM) + EPS) : 1.0f; bf16_t* rowp = O + (size_t)row * ldc + col0;
#pragma unroll
                for (int bj = 0; bj < 2; ++bj) { const f32x4 v0 = acc[ai][bj][m][0] * rs, v1 = acc[ai][bj][m][1] * rs;
                    u32x4 w; w.x = pk2(v0[0], v0[1]); w.y = pk2(v0[2], v0[3]); w.z = pk2(v1[0], v1[1]); w.w = pk2(v1[2], v1[3]);
                    *(u32x4*)(rowp + bj * 128) = w; } }
    }
};
struct EpiRes {
    static constexpr bool PERM = false;
    const float* base; float* out; bf16_t* ob; float* ssq;
    __device__ __forceinline__ void operator()(const f32x4 (&acc)[2][2][4][2], const pg8::Unit& u, int wr, int wc, int fr, int fq) const {
        const int row0 = u.pm * 256 + wr * 64 + fr, col0 = u.pn * 256 + wc * 32 + 4 * fq;
#pragma unroll
        for (int ai = 0; ai < 2; ++ai)
#pragma unroll
            for (int m = 0; m < 4; ++m) { const int row = row0 + ai * 128 + m * 16; const size_t off = (size_t)row * DM + col0; float ss = 0.f;
#pragma unroll
                for (int bj = 0; bj < 2; ++bj)
#pragma unroll
                    for (int n = 0; n < 2; ++n) { const f32x4 b = *(const f32x4*)(base + off + bj * 128 + n * 16); const f32x4 v = b + acc[ai][bj][m][n];
                        *(f32x4*)(out + off + bj * 128 + n * 16) = v; ss += (v[0] * v[0] + v[1] * v[1]) + (v[2] * v[2] + v[3] * v[3]);
                        if (ob) { u32x2 w; w.x = pk2(v[0], v[1]); w.y = pk2(v[2], v[3]); *(u32x2*)(ob + off + bj * 128 + n * 16) = w; } }
                ss += __shfl_xor(ss, 16); ss += __shfl_xor(ss, 32);
                if (fq == 0) atomicAdd(ssq + row, ss);
                asm volatile("" ::: "memory"); }
    }
};

struct Params { const float* in[16]; float* out; unsigned char* ws; int ph_lo, ph_hi; };
enum { I_X = 0, I_N1W, I_WIN, I_CONVQ, I_ALOG, I_DTB, I_ONW, I_POOLW, I_POOLS, I_WOUT, I_N2W, I_WUP, I_CONVF, I_CONVFB, I_WDOWN, I_FNW };

__device__ __forceinline__ void tr_item(const float* W, int ldw, int col0, int nvalid, bf16_t* WT, int ldk, int row0, int k0, const float* kscale, const float* nscale, LAS float* scr, int lane) {
    const int n = lane & 31;
#pragma unroll 8
    for (int i = 0; i < 32; ++i) { const int kk = 2 * i + (lane >> 5); float v = (n < nvalid) ? W[(size_t)(k0 + kk) * ldw + col0 + n] : 0.f; if (kscale) v *= kscale[k0 + kk]; scr[kk * 33 + n] = v; }
    asm volatile("s_waitcnt lgkmcnt(0)" ::: "memory");
    const int c = lane & 7;
#pragma unroll
    for (int j = 0; j < 4; ++j) { const int nn = (lane >> 3) + 8 * j; const LAS float* s = scr + (8 * c) * 33 + nn; const float sc = nscale ? nscale[nn] : 1.0f;
        u32x4 o; o.x = pk2(s[0 * 33] * sc, s[1 * 33] * sc); o.y = pk2(s[2 * 33] * sc, s[3 * 33] * sc); o.z = pk2(s[4 * 33] * sc, s[5 * 33] * sc); o.w = pk2(s[6 * 33] * sc, s[7 * 33] * sc);
        *(u32x4*)(WT + (size_t)(row0 + nn) * ldk + k0 + 8 * c) = o; }
    asm volatile("s_waitcnt lgkmcnt(0)" ::: "memory");
}

__device__ __forceinline__ void tr64_item(const float* W, int ldw, int col0, bf16_t* WT, int ldk, int row0, int k0, const float* kscale, const float* nscale, LAS float* scr, int lane) {
    f32x4 v[16];
    const int l15 = lane & 15, lq = lane >> 4;
#pragma unroll
    for (int i = 0; i < 16; ++i) v[i] = *(const f32x4*)(W + (size_t)(k0 + 4 * i + lq) * ldw + col0 + 4 * l15);
    if (kscale) {
#pragma unroll
        for (int i = 0; i < 16; ++i) v[i] = v[i] * kscale[k0 + 4 * i + lq];
    }
#pragma unroll
    for (int i = 0; i < 16; ++i) { LAS float* d = scr + (4 * i + lq) * 65 + 4 * l15; d[0] = v[i][0]; d[1] = v[i][1]; d[2] = v[i][2]; d[3] = v[i][3]; }
    asm volatile("s_waitcnt lgkmcnt(0)" ::: "memory");
    const int c = lane & 7;
#pragma unroll
    for (int j = 0; j < 8; ++j) { const int nn = (lane >> 3) + 8 * j; const LAS float* sp = scr + (8 * c) * 65 + nn; const float sc = nscale ? nscale[nn] : 1.0f;
        u32x4 o; o.x = pk2(sp[0 * 65] * sc, sp[1 * 65] * sc); o.y = pk2(sp[2 * 65] * sc, sp[3 * 65] * sc); o.z = pk2(sp[4 * 65] * sc, sp[5 * 65] * sc); o.w = pk2(sp[6 * 65] * sc, sp[7 * 65] * sc);
        *(u32x4*)(WT + (size_t)(row0 + nn) * ldk + k0 + 8 * c) = o; }
    asm volatile("s_waitcnt lgkmcnt(0)" ::: "memory");
}
__device__ __forceinline__ float wave_sum(float v) {
#pragma unroll
    for (int o = 1; o < 64; o <<= 1) v += __shfl_xor(v, o);
    return v;
}
__device__ __forceinline__ void phase_prep(const Params& p, LAS unsigned char* lds) {
    const int tid = threadIdx.x, lane = tid & 63, wave = tid >> 6;
    const int gw = blockIdx.x * 8 + wave, NGW = gridDim.x * 8;
    unsigned char* ws = p.ws;
    LAS float* scr = (LAS float*)(lds + wave * 16640);
    bf16_t* WinT = (bf16_t*)(ws + OFF_WIN); bf16_t* WoutT = (bf16_t*)(ws + OFF_WOUT); bf16_t* PoolT = (bf16_t*)(ws + OFF_POOLT);
    constexpr int I_A = 32 * 64, I_B = 32 * 16, I_C = 32, I_O = 32 * 32, I_P = 64;
    constexpr int NIT = I_A + I_B + I_C + I_O + I_P;
    for (int it = gw; it < NIT; it += NGW) {
        int r = it;
        if (r < I_A) { const int kb = r / 64, nb = r % 64; tr64_item(p.in[I_WIN], INW, 64 * nb, WinT, DM, 64 * nb, 64 * kb, p.in[I_N1W], nullptr, scr, lane); continue; } r -= I_A;
        if (r < I_B) { const int kb = r / 16, nb = r % 16; tr64_item(p.in[I_WIN], INW, 4112 + 64 * nb, WinT, DM, 4096 + 64 * nb, 64 * kb, p.in[I_N1W], nullptr, scr, lane); continue; } r -= I_B;
        if (r < I_C) { tr_item(p.in[I_WIN], INW, 4096, 16, WinT, DM, 5120, 64 * r, p.in[I_N1W], nullptr, scr, lane); continue; } r -= I_C;
        if (r < I_O) { const int kb = r / 32, nb = r % 32; tr64_item(p.in[I_WOUT], DM, 64 * nb, WoutT, DM, 64 * nb, 64 * kb, nullptr, nullptr, scr, lane); continue; } r -= I_O;
        { const int g = r / 16, kb = (r % 16) / 4, nb = r % 4; tr64_item(p.in[I_POOLW] + (size_t)g * 65536, 256, 64 * nb, PoolT + (size_t)g * 65536, 256, 64 * nb, 64 * kb, nullptr, p.in[I_POOLS] + g * 256 + 64 * nb, scr, lane); }
    }
    { u32x4* z = (u32x4*)(WinT + (size_t)5152 * DM); const int nz = (N1 - 5152) * DM / 8;
      for (int i = blockIdx.x * 512 + tid; i < nz; i += gridDim.x * 512) z[i] = (u32x4){0u, 0u, 0u, 0u}; }
    { float* z = (float*)(ws + OFF_SSQ2); for (int i = blockIdx.x * 512 + tid; i < 2 * MTOK; i += gridDim.x * 512) z[i] = 0.f; }
    bf16_t* XB = (bf16_t*)(ws + OFF_XB); float* rstd1 = (float*)(ws + OFF_RSTD1);
    for (int m = gw; m < MTOK; m += NGW) {
        const f32x4* xr = (const f32x4*)(p.in[I_X] + (size_t)m * DM) + lane; f32x4 v[8]; float s = 0.f;
#pragma unroll
        for (int j = 0; j < 8; ++j) { v[j] = xr[64 * j]; s += (v[j][0] * v[j][0] + v[j][1] * v[j][1]) + (v[j][2] * v[j][2] + v[j][3] * v[j][3]); }
        s = wave_sum(s);
        if (lane == 0) rstd1[m] = rsqrtf(s * (1.0f / DM) + EPS);
        u32x2* o = (u32x2*)(XB + (size_t)m * DM) + lane;
#pragma unroll
        for (int j = 0; j < 8; ++j) { u32x2 w; w.x = pk2(v[j][0], v[j][1]); w.y = pk2(v[j][2], v[j][3]); o[64 * j] = w; }
    }
}


__device__ __forceinline__ void phase_prep2(const Params& p, LAS unsigned char* lds, int vw, int nvw) {
    const int lane = threadIdx.x & 63, wave = threadIdx.x >> 6;
    LAS float* scr = (LAS float*)(lds + wave * 16640);
    bf16_t* WupT = (bf16_t*)(p.ws + OFF_WUP); bf16_t* WdownT = (bf16_t*)(p.ws + OFF_WDOWN);
    constexpr int I_U = 32 * 176, I_D = 88 * 32;
    for (int it = vw; it < I_U + I_D; it += nvw) {
        if (it < I_U) { const int kb = it / 176, nb = it % 176; tr64_item(p.in[I_WUP], NUP, 64 * nb, WupT, DM, 64 * nb, 64 * kb, p.in[I_N2W], nullptr, scr, lane); }
        else { const int r = it - I_U, kb = r / 32, nb = r % 32; tr64_item(p.in[I_WDOWN], DM, 64 * nb, WdownT, DFF, 64 * nb, 64 * kb, nullptr, nullptr, scr, lane); }
    }
}

constexpr int CP_Q = 0, CP_K = 33792, CP_V = 67584, CP_L = 101376, CP_MISC = 118784;
__device__ __forceinline__ void chunk_prep(const Params& p, LAS unsigned char* lds, int item) {
    const int tid = threadIdx.x, lane = tid & 63, wave = tid >> 6;
    const int b = item >> 8, h = (item >> 5) & 7, n = item & 31;
    const int t0 = b * SEQ + n * CH, tl0 = n * CH;
    unsigned char* ws = p.ws;
    const bf16_t* proj = (const bf16_t*)(ws + OFF_PROJ);
    const float* logits = (const float*)(ws + OFF_LOGIT);
    unsigned char* cb = ws + OFF_CHUNK + (size_t)item * CHUNK_BYTES;
    float* value_o = (float*)cb; bf16_t* kcum_o = (bf16_t*)(cb + 32768); bf16_t* qg_o = (bf16_t*)(cb + 49152); bf16_t* ktT_o = (bf16_t*)(cb + 65536); bf16_t* qk_o = (bf16_t*)(cb + 81920);
    LAS float* qS = (LAS float*)(lds + CP_Q); LAS float* kS = (LAS float*)(lds + CP_K); LAS float* vS = (LAS float*)(lds + CP_V); LAS float* Ls = (LAS float*)(lds + CP_L);
    LAS float* betaS = (LAS float*)(lds + CP_MISC); LAS float* gcS = betaS + 64; LAS float* sclk = betaS + 128; LAS float* egS = betaS + 192; LAS float* etS = betaS + 256;
    const float* cw = p.in[I_CONVQ];
    for (int it = tid; it < 3072; it += 512) {
        const int mat = it >> 10, r = (it & 1023) >> 4, c = (it & 15) * 8;
        const int col = mat * 1024 + h * HD + c;
        float a[8];
#pragma unroll
        for (int e = 0; e < 8; ++e) a[e] = 0.f;
#pragma unroll
        for (int j = 0; j < 4; ++j) {
            if (tl0 + r - 3 + j >= 0) {
                const u32x4 raw = *(const u32x4*)(proj + (size_t)(t0 + r - 3 + j) * NPROJ + col);
                const f32x4 w0 = *(const f32x4*)(cw + j * 3072 + col), w1 = *(const f32x4*)(cw + j * 3072 + col + 4);
                a[0] += w0[0] * bflo(raw.x); a[1] += w0[1] * bfhi(raw.x); a[2] += w0[2] * bflo(raw.y); a[3] += w0[3] * bfhi(raw.y);
                a[4] += w1[0] * bflo(raw.z); a[5] += w1[1] * bfhi(raw.z); a[6] += w1[2] * bflo(raw.w); a[7] += w1[3] * bfhi(raw.w);
            }
        }
        LAS float* dst = (mat == 0 ? qS : (mat == 1 ? kS : vS)) + r * 132 + c;
        *(LAS f32x4*)dst = (f32x4){silu_f(a[0]), silu_f(a[1]), silu_f(a[2]), silu_f(a[3])};
        *(LAS f32x4*)(dst + 4) = (f32x4){silu_f(a[4]), silu_f(a[5]), silu_f(a[6]), silu_f(a[7])};
    }
    __syncthreads();
    {
        const int row = tid >> 2, part = tid & 3;
        LAS float* base = (row < 64 ? qS + row * 132 : kS + (row - 64) * 132) + part * 32;
        f32x4 v[8]; float ss = 0.f;
#pragma unroll
        for (int e = 0; e < 8; ++e) { v[e] = *(LAS f32x4*)(base + 4 * e); ss += (v[e][0] * v[e][0] + v[e][1] * v[e][1]) + (v[e][2] * v[e][2] + v[e][3] * v[e][3]); }
        ss += __shfl_xor(ss, 1); ss += __shfl_xor(ss, 2);
        const float sc = rsqrtf(ss + EPS) * (row < 64 ? 0.08838834764831845f : 1.0f);
#pragma unroll
        for (int e = 0; e < 8; ++e) *(LAS f32x4*)(base + 4 * e) = v[e] * sc;
    }
    if (wave == 0) {
        const float lb = logits[(size_t)(t0 + lane) * 16 + h], la = logits[(size_t)(t0 + lane) * 16 + 8 + h];
        const float beta = 1.0f / (1.0f + __expf(-lb));
        const float x = la + p.in[I_DTB][h];
        const float sp = fmaxf(x, 0.f) + log1pf(__expf(-fabsf(x)));
        float g = -__expf(p.in[I_ALOG][h]) * sp;
#pragma unroll
        for (int o = 1; o < 64; o <<= 1) { const float t = __shfl_up(g, o); if (lane >= o) g += t; }
        const float gl = __shfl(g, 63);
        const float eg = __expf(g);
        betaS[lane] = beta; gcS[lane] = g; sclk[lane] = beta * eg; egS[lane] = eg; etS[lane] = __expf(gl - g);
        if (lane == 63) ((float*)(ws + OFF_GLAST))[item] = eg;
    }
    __syncthreads();
    {
        const int half = tid >> 8, t = tid & 255, ty = t >> 4, tx = t & 15;
        const LAS float* A = half ? qS : kS;
        float acc[4][4];
#pragma unroll
        for (int i = 0; i < 4; ++i)
#pragma unroll
            for (int j = 0; j < 4; ++j) acc[i][j] = 0.f;
#pragma unroll 4
        for (int d = 0; d < HD; d += 4) {
            f32x4 av[4], bv[4];
#pragma unroll
            for (int i = 0; i < 4; ++i) { av[i] = *(const LAS f32x4*)(A + (ty + 16 * i) * 132 + d); bv[i] = *(const LAS f32x4*)(kS + (tx + 16 * i) * 132 + d); }
#pragma unroll
            for (int i = 0; i < 4; ++i)
#pragma unroll
                for (int j = 0; j < 4; ++j) acc[i][j] += (av[i][0] * bv[j][0] + av[i][1] * bv[j][1]) + (av[i][2] * bv[j][2] + av[i][3] * bv[j][3]);
        }
#pragma unroll
        for (int i = 0; i < 4; ++i)
#pragma unroll
            for (int j = 0; j < 4; ++j) { const int ii = ty + 16 * i, jj = tx + 16 * j;
                const float dec = (ii >= jj) ? __expf(gcS[ii] - gcS[jj]) : 0.f;
                if (half == 0) Ls[ii * 68 + jj] = (ii > jj) ? betaS[ii] * acc[i][j] * dec : 0.f;
                else { const unsigned w = pk2(acc[i][j] * dec, 0.f); qk_o[ii * 64 + jj] = (bf16_t)(w & 0xffffu); } }
    }
    __syncthreads();
    if (tid < 256) {
        const int c = tid;
        unsigned msb = (c < 128) ? (unsigned)(CP_V + 4 * c) : (unsigned)(CP_K + 4 * (c - 128)), sclb = (c < 128) ? (unsigned)CP_MISC : (unsigned)(CP_MISC + 512), lsb = CP_L;
        asm volatile("" : "+v"(msb), "+v"(sclb), "+v"(lsb));
        const LAS float* Msrc = (const LAS float*)(lds + msb);
        const LAS float* scl = (const LAS float*)(lds + sclb);
        const LAS float* Lsr = (const LAS float*)(lds + lsb);
        float sol[64];
#pragma unroll
        for (int i = 0; i < 64; ++i) {
            float a = Msrc[i * 132] * scl[i];
#pragma unroll
            for (int j4 = 0; j4 < i; j4 += 4) {
                const f32x4 l = *(const LAS f32x4*)(Lsr + i * 68 + j4);
                a -= l[0] * sol[j4];
                if (j4 + 1 < i) a -= l[1] * sol[j4 + 1];
                if (j4 + 2 < i) a -= l[2] * sol[j4 + 2];
                if (j4 + 3 < i) a -= l[3] * sol[j4 + 3];
            }
            sol[i] = a;
            if (c < 128) value_o[i * 128 + c] = a;
            else { const unsigned w = pk2(-a, 0.f); kcum_o[i * 128 + (c - 128)] = (bf16_t)(w & 0xffffu); }
        }
    } else {
        const int t = tid - 256;
        for (int it = t; it < 1024; it += 256) { const int i = it >> 4, c = (it & 15) * 8; const float e = egS[i];
            const f32x4 a = *(const LAS f32x4*)(qS + i * 132 + c) * e, bq = *(const LAS f32x4*)(qS + i * 132 + c + 4) * e;
            u32x4 w; w.x = pk2(a[0], a[1]); w.y = pk2(a[2], a[3]); w.z = pk2(bq[0], bq[1]); w.w = pk2(bq[2], bq[3]);
            *(u32x4*)(qg_o + i * 128 + c) = w; }
        for (int it = t; it < 1024; it += 256) { const int d = it & 127, i0 = (it >> 7) * 8; float v[8];
#pragma unroll
            for (int e = 0; e < 8; ++e) v[e] = kS[(i0 + e) * 132 + d] * etS[i0 + e];
            u32x4 w; w.x = pk2(v[0], v[1]); w.y = pk2(v[2], v[3]); w.z = pk2(v[4], v[5]); w.w = pk2(v[6], v[7]);
            *(u32x4*)(ktT_o + d * 64 + i0) = w; }
    }
    __syncthreads();
}
__device__ __forceinline__ void pool_diff(const Params& p) {
    unsigned char* ws = p.ws;
    const bf16_t* proj = (const bf16_t*)(ws + OFF_PROJ); bf16_t* dp = (bf16_t*)(ws + OFF_DPOOL);
    for (int it = blockIdx.x * 512 + threadIdx.x; it < MTOK * 128; it += gridDim.x * 512) {
        const int t = it >> 7, c = (it & 127) * 8, g = c >> 8, w = 2 << g, tl = t & (SEQ - 1);
        const int cnt = (tl + 1 < w) ? tl + 1 : w;
        const bf16_t* src = proj + (size_t)t * NPROJ + 4096 + c;
        float s[8], u0[8];
        { const u32x4 raw = *(const u32x4*)src; u0[0] = bflo(raw.x); u0[1] = bfhi(raw.x); u0[2] = bflo(raw.y); u0[3] = bfhi(raw.y); u0[4] = bflo(raw.z); u0[5] = bfhi(raw.z); u0[6] = bflo(raw.w); u0[7] = bfhi(raw.w); }
#pragma unroll
        for (int e = 0; e < 8; ++e) s[e] = u0[e];
        for (int j = 1; j < cnt; ++j) { const u32x4 raw = *(const u32x4*)(src - (size_t)j * NPROJ);
            s[0] += bflo(raw.x); s[1] += bfhi(raw.x); s[2] += bflo(raw.y); s[3] += bfhi(raw.y); s[4] += bflo(raw.z); s[5] += bfhi(raw.z); s[6] += bflo(raw.w); s[7] += bfhi(raw.w); }
        const float inv = 1.0f / (float)cnt;
        u32x4 o; o.x = pk2(s[0] * inv - u0[0], s[1] * inv - u0[1]); o.y = pk2(s[2] * inv - u0[2], s[3] * inv - u0[3]); o.z = pk2(s[4] * inv - u0[4], s[5] * inv - u0[5]); o.w = pk2(s[6] * inv - u0[6], s[7] * inv - u0[7]);
        *(u32x4*)(dp + (size_t)t * 1024 + c) = o;
    }
}

constexpr int SC_KC = 0, SC_QG = 16896, SC_KT = 33792, SC_QK = 51200, SC_OT = 59904;
__device__ __forceinline__ bf16x8 packh(const f32x16& x, int s) {
    u32x4 r; r.x = pk2(x[8 * s + 0], x[8 * s + 1]); r.y = pk2(x[8 * s + 2], x[8 * s + 3]); r.z = pk2(x[8 * s + 4], x[8 * s + 5]); r.w = pk2(x[8 * s + 6], x[8 * s + 7]);
    return __builtin_bit_cast(bf16x8, r);
}
__device__ __forceinline__ bf16x8 frag_rd(const LAS unsigned char* base, int byteoff) {
    const u32x2 lo = *(const LAS u32x2*)(base + byteoff), hi = *(const LAS u32x2*)(base + byteoff + 16);
    u32x4 r; r.x = lo.x; r.y = lo.y; r.z = hi.x; r.w = hi.y; return __builtin_bit_cast(bf16x8, r);
}
#define SC_BAR() do { asm volatile("s_waitcnt lgkmcnt(0)" ::: "memory"); __builtin_amdgcn_s_barrier(); asm volatile("" ::: "memory"); } while (0)
__device__ __forceinline__ void scan_compute(const Params& p, LAS unsigned char* lds, int bh, int wave, int lane) {
    unsigned char* ws = p.ws;
    const float* glast = (const float*)(ws + OFF_GLAST) + bh * 32;
    const int r = lane & 31, hh = lane >> 5;
    const unsigned char* cb0 = ws + OFF_CHUNK + (size_t)(bh * 32) * CHUNK_BYTES;
    const int voff = (4 * hh) * 128 + 32 * wave + r;
    f32x16 S[4]; bf16x8 Sb[8]; f32x16 vn[2];
#pragma unroll
    for (int i = 0; i < 4; ++i)
#pragma unroll
        for (int e = 0; e < 16; ++e) S[i][e] = 0.f;
#pragma unroll
    for (int i = 0; i < 8; ++i) Sb[i] = (bf16x8){0, 0, 0, 0, 0, 0, 0, 0};
    {
        const float* val = (const float*)cb0 + voff;
#pragma unroll
        for (int mi = 0; mi < 2; ++mi)
#pragma unroll
            for (int i = 0; i < 16; ++i) vn[mi][i] = val[(32 * mi + (i & 3) + 8 * (i >> 2)) * 128];
    }
    SC_BAR();
    for (int n = 0; n < NCH; ++n) {
        LAS float* oT = (LAS float*)(lds + SC_OT + (n & 1) * 33792);
        f32x16 vnx[2];
        {
            const int nn = (n + 1 < NCH) ? n + 1 : n;
            const float* val = (const float*)(cb0 + (size_t)nn * CHUNK_BYTES) + voff;
#pragma unroll
            for (int mi = 0; mi < 2; ++mi)
#pragma unroll
                for (int i = 0; i < 16; ++i) vnx[mi][i] = val[(32 * mi + (i & 3) + 8 * (i >> 2)) * 128];
        }
        const float gl = glast[n];
        f32x16 o[2];
#pragma unroll
        for (int mi = 0; mi < 2; ++mi) {
#pragma unroll
            for (int e = 0; e < 16; ++e) o[mi][e] = 0.f;
#pragma unroll
            for (int ks = 0; ks < 8; ++ks) {
                const int off = (32 * mi + r) * 264 + (16 * ks + 4 * hh) * 2;
                vn[mi] = __builtin_amdgcn_mfma_f32_32x32x16_bf16(frag_rd(lds + SC_KC, off), Sb[ks], vn[mi], 0, 0, 0);
                o[mi] = __builtin_amdgcn_mfma_f32_32x32x16_bf16(frag_rd(lds + SC_QG, off), Sb[ks], o[mi], 0, 0, 0);
            }
        }
        bf16x8 vb[4];
#pragma unroll
        for (int ks = 0; ks < 4; ++ks) vb[ks] = packh(vn[ks >> 1], ks & 1);
#pragma unroll
        for (int mi = 0; mi < 2; ++mi)
#pragma unroll
            for (int ks = 0; ks < 4; ++ks)
                o[mi] = __builtin_amdgcn_mfma_f32_32x32x16_bf16(frag_rd(lds + SC_QK, (32 * mi + r) * 136 + (16 * ks + 4 * hh) * 2), vb[ks], o[mi], 0, 0, 0);
#pragma unroll
        for (int mi = 0; mi < 2; ++mi)
#pragma unroll
            for (int i = 0; i < 16; ++i) oT[(32 * mi + (i & 3) + 8 * (i >> 2) + 4 * hh) * 132 + 32 * wave + r] = o[mi][i];
#pragma unroll
        for (int mt = 0; mt < 4; ++mt) {
            S[mt] = S[mt] * gl;
#pragma unroll
            for (int ks = 0; ks < 4; ++ks)
                S[mt] = __builtin_amdgcn_mfma_f32_32x32x16_bf16(frag_rd(lds + SC_KT, (32 * mt + r) * 136 + (16 * ks + 4 * hh) * 2), vb[ks], S[mt], 0, 0, 0);
            Sb[2 * mt] = packh(S[mt], 0); Sb[2 * mt + 1] = packh(S[mt], 1);
        }
        vn[0] = vnx[0]; vn[1] = vnx[1];
        SC_BAR();
        SC_BAR();
    }
}
__device__ __forceinline__ void scan_finalize(const LAS float* oP, const u32x4 (&zr)[4], const float (&onw)[32], bf16_t* mp) {
    f32x4 v[8]; float ss = 0.f;
#pragma unroll
    for (int e = 0; e < 8; ++e) { v[e] = *(const LAS f32x4*)(oP + 4 * e); ss += (v[e][0] * v[e][0] + v[e][1] * v[e][1]) + (v[e][2] * v[e][2] + v[e][3] * v[e][3]); }
    ss += __shfl_xor(ss, 1); ss += __shfl_xor(ss, 2);
    const float rs = rsqrtf(ss * (1.0f / HD) + EPS);
#pragma unroll
    for (int q = 0; q < 4; ++q) {
        const f32x4 a = v[2 * q] * rs, c2 = v[2 * q + 1] * rs; const u32x4 z = zr[q];
        u32x4 w;
        w.x = pk2(a[0] * onw[8 * q + 0] * silu_f(bflo(z.x)), a[1] * onw[8 * q + 1] * silu_f(bfhi(z.x)));
        w.y = pk2(a[2] * onw[8 * q + 2] * silu_f(bflo(z.y)), a[3] * onw[8 * q + 3] * silu_f(bfhi(z.y)));
        w.z = pk2(c2[0] * onw[8 * q + 4] * silu_f(bflo(z.z)), c2[1] * onw[8 * q + 5] * silu_f(bfhi(z.z)));
        w.w = pk2(c2[2] * onw[8 * q + 6] * silu_f(bflo(z.w)), c2[3] * onw[8 * q + 7] * silu_f(bfhi(z.w)));
        *(u32x4*)(mp + 8 * q) = w;
    }
}
__device__ __forceinline__ void scan_loader(const Params& p, LAS unsigned char* lds, int bh, int lt) {
    unsigned char* ws = p.ws;
    const int b = bh >> 3, h = bh & 7;
    const bf16_t* proj = (const bf16_t*)(ws + OFF_PROJ); bf16_t* mix = (bf16_t*)(ws + OFF_MIX);
    const unsigned char* src0 = ws + OFF_CHUNK + (size_t)(bh * 32) * CHUNK_BYTES + 32768 + lt * 16;
    const int frow = lt >> 2, fpart = lt & 3;
    int sdst[14];
#pragma unroll
    for (int i = 0; i < 14; ++i) {
        int q = lt + 256 * i;
        if (i < 4) sdst[i] = SC_KC + (q >> 4) * 264 + (q & 15) * 16;
        else if (i < 8) { q -= 1024; sdst[i] = SC_QG + (q >> 4) * 264 + (q & 15) * 16; }
        else if (i < 12) { q -= 2048; sdst[i] = SC_KT + (q >> 3) * 136 + (q & 7) * 16; }
        else { q -= 3072; sdst[i] = SC_QK + (q >> 3) * 136 + (q & 7) * 16; }
    }
    float onw[32];
#pragma unroll
    for (int e = 0; e < 32; ++e) onw[e] = p.in[I_ONW][32 * fpart + e];
    u32x4 stg[14];
#pragma unroll
    for (int i = 0; i < 14; ++i) stg[i] = *(const u32x4*)(src0 + i * 4096);
#pragma unroll
    for (int i = 0; i < 14; ++i) { *(LAS u32x2*)(lds + sdst[i]) = (u32x2){stg[i].x, stg[i].y}; *(LAS u32x2*)(lds + sdst[i] + 8) = (u32x2){stg[i].z, stg[i].w}; }
    SC_BAR();
    const bf16_t* zbase = proj + (size_t)(b * SEQ + frow) * NPROJ + 3072 + h * HD + 32 * fpart;
    bf16_t* mbase = mix + (size_t)(b * SEQ + frow) * DM + h * HD + 32 * fpart;
    for (int n = 0; n < NCH; ++n) {
        u32x4 zr[4];
        if (n >= 1) {
#pragma unroll
            for (int q = 0; q < 4; ++q) zr[q] = *(const u32x4*)(zbase + (size_t)(n - 1) * CH * NPROJ + 8 * q);
        }
        {
            const int nn = (n + 1 < NCH) ? n + 1 : n;
#pragma unroll
            for (int i = 0; i < 14; ++i) stg[i] = *(const u32x4*)(src0 + (size_t)nn * CHUNK_BYTES + i * 4096);
        }
        if (n >= 1) scan_finalize((const LAS float*)(lds + SC_OT + ((n - 1) & 1) * 33792) + frow * 132 + 32 * fpart, zr, onw, mbase + (size_t)(n - 1) * CH * DM);
        SC_BAR();
        if (n + 1 < NCH) {
#pragma unroll
            for (int i = 0; i < 14; ++i) { *(LAS u32x2*)(lds + sdst[i]) = (u32x2){stg[i].x, stg[i].y}; *(LAS u32x2*)(lds + sdst[i] + 8) = (u32x2){stg[i].z, stg[i].w}; }
        }
        SC_BAR();
    }
    {
        u32x4 zr[4];
#pragma unroll
        for (int q = 0; q < 4; ++q) zr[q] = *(const u32x4*)(zbase + (size_t)(NCH - 1) * CH * NPROJ + 8 * q);
        scan_finalize((const LAS float*)(lds + SC_OT + ((NCH - 1) & 1) * 33792) + frow * 132 + 32 * fpart, zr, onw, mbase + (size_t)(NCH - 1) * CH * DM);
    }
}
__device__ __forceinline__ void scan_phase(const Params& p, LAS unsigned char* lds, int bh) {
    const int tid = threadIdx.x, wave = __builtin_amdgcn_readfirstlane(tid >> 6);
    if (wave < 4) scan_compute(p, lds, bh, wave, tid & 63);
    else scan_loader(p, lds, bh, tid & 255);
    __syncthreads();
}

__device__ __forceinline__ void act_phase(const Params& p) {
    unsigned char* ws = p.ws;
    const bf16_t* up = (const bf16_t*)(ws + OFF_UP); bf16_t* act = (bf16_t*)(ws + OFF_ACT);
    const float* cw = p.in[I_CONVF]; const float* cbias = p.in[I_CONVFB];
    constexpr int NCG = DFF / 8, RB = 32;
    for (int it = blockIdx.x * 512 + threadIdx.x; it < (MTOK / RB) * NCG; it += gridDim.x * 512) {
        const int cgp = it % NCG, rb = it / NCG, c = cgp * 8, t0 = rb * RB;
        float wg[3][8], wv[3][8], bg[8], bv[8];
#pragma unroll
        for (int j = 0; j < 3; ++j)
#pragma unroll
            for (int e = 0; e < 8; ++e) { wg[j][e] = cw[j * NUP + c + e]; wv[j][e] = cw[j * NUP + DFF + c + e]; }
#pragma unroll
        for (int e = 0; e < 8; ++e) { bg[e] = cbias[c + e]; bv[e] = cbias[DFF + c + e]; }
        float g2[8], g1[8], v2[8], v1[8];
        const bool first = ((t0 & (SEQ - 1)) == 0);
#pragma unroll
        for (int e = 0; e < 8; ++e) { g2[e] = 0.f; g1[e] = 0.f; v2[e] = 0.f; v1[e] = 0.f; }
        if (!first) {
            const u32x4 a = *(const u32x4*)(up + (size_t)(t0 - 2) * NUP + c), b2 = *(const u32x4*)(up + (size_t)(t0 - 1) * NUP + c);
            const u32x4 cc = *(const u32x4*)(up + (size_t)(t0 - 2) * NUP + DFF + c), d = *(const u32x4*)(up + (size_t)(t0 - 1) * NUP + DFF + c);
            g2[0] = bflo(a.x); g2[1] = bfhi(a.x); g2[2] = bflo(a.y); g2[3] = bfhi(a.y); g2[4] = bflo(a.z); g2[5] = bfhi(a.z); g2[6] = bflo(a.w); g2[7] = bfhi(a.w);
            g1[0] = bflo(b2.x); g1[1] = bfhi(b2.x); g1[2] = bflo(b2.y); g1[3] = bfhi(b2.y); g1[4] = bflo(b2.z); g1[5] = bfhi(b2.z); g1[6] = bflo(b2.w); g1[7] = bfhi(b2.w);
            v2[0] = bflo(cc.x); v2[1] = bfhi(cc.x); v2[2] = bflo(cc.y); v2[3] = bfhi(cc.y); v2[4] = bflo(cc.z); v2[5] = bfhi(cc.z); v2[6] = bflo(cc.w); v2[7] = bfhi(cc.w);
            v1[0] = bflo(d.x); v1[1] = bfhi(d.x); v1[2] = bflo(d.y); v1[3] = bfhi(d.y); v1[4] = bflo(d.z); v1[5] = bfhi(d.z); v1[6] = bflo(d.w); v1[7] = bfhi(d.w);
        }
#pragma unroll 4
        for (int rr = 0; rr < RB; ++rr) {
            const int t = t0 + rr;
            const u32x4 a = *(const u32x4*)(up + (size_t)t * NUP + c), d = *(const u32x4*)(up + (size_t)t * NUP + DFF + c);
            float g0[8] = {bflo(a.x), bfhi(a.x), bflo(a.y), bfhi(a.y), bflo(a.z), bfhi(a.z), bflo(a.w), bfhi(a.w)};
            float v0[8] = {bflo(d.x), bfhi(d.x), bflo(d.y), bfhi(d.y), bflo(d.z), bfhi(d.z), bflo(d.w), bfhi(d.w)};
            float o[8];
#pragma unroll
            for (int e = 0; e < 8; ++e) {
                const float G = wg[0][e] * g2[e] + wg[1][e] * g1[e] + wg[2][e] * g0[e] + bg[e];
                const float V = wv[0][e] * v2[e] + wv[1][e] * v1[e] + wv[2][e] * v0[e] + bv[e];
                o[e] = silu_f(G) * V; g2[e] = g1[e]; g1[e] = g0[e]; v2[e] = v1[e]; v1[e] = v0[e];
            }
            u32x4 w; w.x = pk2(o[0], o[1]); w.y = pk2(o[2], o[3]); w.z = pk2(o[4], o[5]); w.w = pk2(o[6], o[7]);
            *(u32x4*)(act + (size_t)t * DFF + c) = w;
        }
    }
}
__device__ __forceinline__ void final_phase(const Params& p) {
    const float* ssq3 = (const float*)(p.ws + OFF_SSQ3); const float* fw = p.in[I_FNW];
    f32x4* o = (f32x4*)p.out;
    for (int i = blockIdx.x * 512 + threadIdx.x; i < MTOK * DM / 4; i += gridDim.x * 512) {
        const int row = i >> 9, c4 = i & 511;
        const float rs = rsqrtf(ssq3[row] * (1.0f / DM) + EPS);
        const f32x4 w = *(const f32x4*)(fw + 4 * c4);
        o[i] = o[i] * rs * w;
    }
}

constexpr int NPHASE = 9;
template <bool COOP>
__global__ void __launch_bounds__(512, 2) mk_fwd(Params p) {
    extern __shared__ __attribute__((aligned(16))) unsigned char lds_raw[];
    LAS unsigned char* lds = (LAS unsigned char*)lds_raw;
    unsigned char* ws = p.ws;
    const int lo = p.ph_lo, hi = p.ph_hi;
    const int G = gridDim.x, bid = blockIdx.x;
#define IN(k) (lo <= (k) && (k) < hi)
#define SEAM(k) do { if (COOP) { if ((k) + 1 < hi) xcd_barrier(bar); } } while (0)
    XcdBarrier bar; bar.bar = (unsigned*)(ws + OFF_BAR); bar.x = 0; bar.st = (volatile LAS unsigned*)(lds + LDS_MISC);
    if (COOP) {
        if (hi > 1000) cg::this_grid().sync();
        if (threadIdx.x < 4) ((LAS unsigned*)(lds + LDS_MISC))[threadIdx.x] = 0u;
        __syncthreads();
        bar = xcd_barrier_post((unsigned*)(ws + OFF_BAR), (volatile LAS unsigned*)(lds + LDS_MISC));
    }
    if (IN(0)) { phase_prep(p, lds); SEAM(0); }
    if (IN(1)) {
        pg8::Gemm g{(const bf16_t*)(ws + OFF_XB), (const bf16_t*)(ws + OFF_WIN), MTOK, N1, DM, DM, DM, 0};
        pg8::StaticOrder S; S.init(MTOK, N1, G, bid);
        EpiProj E{(bf16_t*)(ws + OFF_PROJ), (float*)(ws + OFF_LOGIT), (const float*)(ws + OFF_RSTD1)};
        pg8::gemm_phase<EpiProj>(lds, g, S, E);
        SEAM(1);
    }
    if (IN(2)) {
        for (int item = bid; item < 1024; item += G) chunk_prep(p, lds, item);
        pool_diff(p);
        SEAM(2);
    }
    if (IN(3)) {
        if (bid < 32) scan_phase(p, lds, bid);
        else {
            pg8::Gemm g{(const bf16_t*)(ws + OFF_DPOOL), (const bf16_t*)(ws + OFF_POOLT), MTOK, 1024, 256, 1024, 256, 512};
            pg8::StaticOrder S; S.init(MTOK, 1024, G - 32, bid - 32);
            EpiBf E{(bf16_t*)(ws + OFF_MIX), DM, 1024, nullptr};
            pg8::gemm_phase<EpiBf>(lds, g, S, E);
            phase_prep2(p, lds, (bid - 32) * 8 + (int)(threadIdx.x >> 6), (G - 32) * 8);
        }
        SEAM(3);
    }
    if (IN(4)) {
        pg8::Gemm g{(const bf16_t*)(ws + OFF_MIX), (const bf16_t*)(ws + OFF_WOUT), MTOK, DM, DM, DM, DM, 0};
        pg8::StaticOrder S; S.init(MTOK, DM, G, bid);
        EpiRes E{p.in[I_X], p.out, (bf16_t*)(ws + OFF_XB), (float*)(ws + OFF_SSQ2)};
        pg8::gemm_phase<EpiRes>(lds, g, S, E);
        SEAM(4);
    }
    if (IN(5)) {
        pg8::Gemm g{(const bf16_t*)(ws + OFF_XB), (const bf16_t*)(ws + OFF_WUP), MTOK, NUP, DM, DM, DM, 0};
        pg8::StaticOrder S; S.init(MTOK, NUP, G, bid);
        EpiBf E{(bf16_t*)(ws + OFF_UP), NUP, 0, (const float*)(ws + OFF_SSQ2)};
        pg8::gemm_phase<EpiBf>(lds, g, S, E);
        SEAM(5);
    }
    if (IN(6)) { act_phase(p); SEAM(6); }
    if (IN(7)) {
        pg8::Gemm g{(const bf16_t*)(ws + OFF_ACT), (const bf16_t*)(ws + OFF_WDOWN), MTOK, DM, DFF, DFF, DFF, 0};
        pg8::StaticOrder S; S.init(MTOK, DM, G, bid);
        EpiRes E{p.out, p.out, nullptr, (float*)(ws + OFF_SSQ3)};
        pg8::gemm_phase<EpiRes>(lds, g, S, E);
        SEAM(7);
    }
    if (IN(8)) { final_phase(p); }
#undef IN
#undef SEAM
}

extern "C" void kernel_launch(void* const* d_in, const int* in_sizes, int n_in, void* d_out, int out_size, void* d_ws, size_t ws_size, hipStream_t stream) {
    static int grid = 0;
    if (!grid) {
        if (n_in != 16 || out_size != MTOK * DM || ws_size < WS_END) { fprintf(stderr, "kernel_launch: unexpected shapes (n_in %d out %d ws %zu, need %zu)\n", n_in, out_size, ws_size, (size_t)WS_END); grid = -1; return; }
        int dev = 0, cus = 0, per_cu = 0;
        hipGetDevice(&dev); hipDeviceGetAttribute(&cus, hipDeviceAttributeMultiprocessorCount, dev);
#if ONE_LAUNCH
        hipFuncSetAttribute((const void*)mk_fwd<true>, hipFuncAttributeMaxDynamicSharedMemorySize, LDS_BYTES);
        hipOccupancyMaxActiveBlocksPerMultiprocessor(&per_cu, mk_fwd<true>, 512, LDS_BYTES);
#else
        hipFuncSetAttribute((const void*)mk_fwd<false>, hipFuncAttributeMaxDynamicSharedMemorySize, LDS_BYTES);
        hipOccupancyMaxActiveBlocksPerMultiprocessor(&per_cu, mk_fwd<false>, 512, LDS_BYTES);
#endif
        if (per_cu < 1) per_cu = 1;
        grid = cus * per_cu;
        if (grid < 64) { fprintf(stderr, "kernel_launch: grid %d too small\n", grid); grid = -1; return; }
    }
    if (grid < 0) return;
    Params p{};
    for (int i = 0; i < 16; ++i) p.in[i] = (const float*)d_in[i];
    p.out = (float*)d_out; p.ws = (unsigned char*)d_ws;
#if ONE_LAUNCH
    p.ph_lo = 0; p.ph_hi = NPHASE;
    void* args[] = {&p};
    if (hipMemsetAsync((unsigned char*)d_ws + OFF_BAR, 0, XCD_BAR_WORDS * 4, stream) != hipSuccess) { fprintf(stderr, "kernel_launch: memset failed\n"); return; }
    hipError_t e = hipLaunchCooperativeKernel((const void*)mk_fwd<true>, dim3(grid), dim3(512), args, LDS_BYTES, stream);
    if (e != hipSuccess) fprintf(stderr, "cooperative launch failed: %s (grid %d)\n", hipGetErrorString(e), grid);
#else
    static const int plist[] = {PLIST};
    for (int ph : plist) { p.ph_lo = ph; p.ph_hi = ph + 1; hipLaunchKernelGGL(mk_fwd<false>, dim3(grid), dim3(512), LDS_BYTES, stream, p); }
#endif
}
```

```cpp
#include <hip/hip_runtime.h>
#include <hip/hip_cooperative_groups.h>
#include <cstdio>
#include <cstdint>
namespace cg = cooperative_groups;

#ifndef ONE_LAUNCH
#define ONE_LAUNCH 1
#endif

#ifndef PLIST
#define PLIST 0,1,2,3,4,5,6,7,8
#endif
#define LAS __attribute__((address_space(3)))
typedef unsigned short bf16_t;
typedef short bf16x8 __attribute__((ext_vector_type(8)));
typedef float f32x4 __attribute__((ext_vector_type(4)));
typedef float f32x2 __attribute__((ext_vector_type(2)));
typedef float f32x16 __attribute__((ext_vector_type(16)));
typedef unsigned u32x4 __attribute__((ext_vector_type(4)));
typedef unsigned u32x2 __attribute__((ext_vector_type(2)));
typedef __bf16 bf16x2_t __attribute__((ext_vector_type(2)));

__device__ __forceinline__ unsigned pk2(float lo, float hi) { f32x2 v = {lo, hi}; bf16x2_t r = __builtin_convertvector(v, bf16x2_t); return __builtin_bit_cast(unsigned, r); }
__device__ __forceinline__ float bflo(unsigned w) { return __uint_as_float(w << 16); }
__device__ __forceinline__ float bfhi(unsigned w) { return __uint_as_float(w & 0xffff0000u); }
__device__ __forceinline__ float silu_f(float x) { return x / (1.0f + __expf(-x)); }

constexpr int SEQ = 2048, DM = 2048, MTOK = 8192;
constexpr int NH = 8, HD = 128, CH = 64, NCH = SEQ / CH;
constexpr int DFF = 5632, NUP = 2 * DFF;
constexpr int INW = 5136, NPROJ = 5120, N1 = 5376;
constexpr float EPS = 1e-6f;

constexpr size_t OFF_WIN = 0;
constexpr size_t OFF_WOUT = OFF_WIN + (size_t)N1 * DM * 2;
constexpr size_t OFF_WUP = OFF_WOUT + (size_t)DM * DM * 2;
constexpr size_t OFF_XB = OFF_WUP + (size_t)NUP * DM * 2;
constexpr size_t OFF_ACT = 0;
constexpr size_t OFF_WDOWN = OFF_XB + (size_t)MTOK * DM * 2;
constexpr size_t OFF_POOLT = OFF_WDOWN + (size_t)DM * DFF * 2;
constexpr size_t OFF_LOGIT = OFF_POOLT + 4 * 256 * 256 * 2;
constexpr size_t OFF_RSTD1 = OFF_LOGIT + (size_t)MTOK * 16 * 4;
constexpr size_t OFF_SSQ2 = OFF_RSTD1 + MTOK * 4;
constexpr size_t OFF_SSQ3 = OFF_SSQ2 + MTOK * 4;
constexpr size_t OFF_GLAST = OFF_SSQ3 + MTOK * 4;
constexpr size_t OFF_BAR = OFF_GLAST + 4096;
constexpr size_t OFF_B = ((OFF_BAR + 16384 + 1048575) / 1048576) * 1048576;
constexpr size_t OFF_UP = OFF_B;
constexpr size_t OFF_PROJ = OFF_B;
constexpr size_t CHUNK_BYTES = 32768 + 16384 * 3 + 8192;
constexpr size_t OFF_CHUNK = OFF_PROJ + (size_t)MTOK * NPROJ * 2;
constexpr size_t OFF_DPOOL = OFF_CHUNK + 1024 * CHUNK_BYTES;
constexpr size_t OFF_MIX = OFF_DPOOL + (size_t)MTOK * 1024 * 2;
constexpr size_t WS_END = OFF_MIX + (size_t)MTOK * DM * 2;
static_assert(OFF_ACT + (size_t)MTOK * DFF * 2 <= OFF_WDOWN, "act overlay");
static_assert(OFF_UP + (size_t)MTOK * NUP * 2 <= WS_END, "up overlay");

constexpr int LDS_BYTES = 147456, LDS_MISC = 147200;
static_assert(WS_END <= 369098752, "workspace budget");


#define XB_TMO      128
#define XB_XCNT(j)  (256  + 64 * (j))
#define XB_XSUB(j)  (1280 + 64 * (j))
#define XB_XGEN(j)  (2304 + 64 * (j))
#define XB_TOP      3328
#define XB_TOPGEN   3392
#define XCD_BAR_WORDS 3456
#define XB_SPIN_CAP (1u << 18)
__device__ __forceinline__ unsigned xb_ld(unsigned* p)              { return __hip_atomic_load(p, __ATOMIC_RELAXED, __HIP_MEMORY_SCOPE_AGENT); }
__device__ __forceinline__ unsigned xb_add(unsigned* p, unsigned v) { return __hip_atomic_fetch_add(p, v, __ATOMIC_RELAXED, __HIP_MEMORY_SCOPE_AGENT); }
__device__ __forceinline__ unsigned xb_xcc_id() { return (unsigned)__builtin_amdgcn_s_getreg((3 << 11) | 20) & 0xFu; }
#define XB_SPIN(cond, bar) do { unsigned _sp = 0; while (cond) { __builtin_amdgcn_s_sleep(1); \
    if ((++_sp & 255u) == 0u) { if (xb_ld(&(bar)[XB_TMO])) break; if (_sp > XB_SPIN_CAP) { atomicAdd(&(bar)[XB_TMO], 1u); break; } } } } while (0)
struct XcdBarrier { unsigned* bar; unsigned x; volatile LAS unsigned* st; };
__device__ __forceinline__ XcdBarrier xcd_barrier_post(unsigned* bar, volatile LAS unsigned* st) {
    XcdBarrier b; b.bar = bar; b.x = xb_xcc_id(); b.st = st;
    if (threadIdx.x == 0) (void)xb_add(&bar[XB_XCNT(b.x)], 1u);
    return b;
}
__device__ __forceinline__ void xcd_barrier_complete(unsigned* bar, unsigned x, unsigned& nloc, unsigned& nx) {
    const unsigned G = gridDim.x * gridDim.y * gridDim.z;
    unsigned sum, cnt, mine, sp = 0u;
    for (;;) {
        sum = 0u; cnt = 0u; mine = 0u;
#pragma unroll
        for (unsigned j = 0; j < 16; ++j) { const unsigned c = xb_ld(&bar[XB_XCNT(j)]); sum += c; cnt += (c > 0u) ? 1u : 0u; mine = (j == x) ? c : mine; }
        if (sum == G) break;
        __builtin_amdgcn_s_sleep(1);
        if ((++sp & 255u) == 0u) { if (xb_ld(&bar[XB_TMO])) break; if (sp > XB_SPIN_CAP) { atomicAdd(&bar[XB_TMO], 1u); break; } }
    }
    nloc = mine > 0u ? mine : 1u; nx = cnt > 0u ? cnt : 1u;
}
__device__ __forceinline__ void xcd_barrier(const XcdBarrier& b) {
    asm volatile("s_waitcnt vmcnt(0)" ::: "memory");
    __syncthreads();
    if (threadIdx.x == 0) {
        unsigned* bar = b.bar;
        __builtin_amdgcn_s_waitcnt(0);
        unsigned nloc = b.st[0], nx = b.st[1];
        if (nloc == 0u) { xcd_barrier_complete(bar, b.x, nloc, nx); b.st[0] = nloc; b.st[1] = nx; }
        const unsigned old = xb_add(&bar[XB_XSUB(b.x)], 1u);
        const unsigned gen = old / nloc;
        if (old + 1u == (gen + 1u) * nloc) {
            __builtin_amdgcn_fence(__ATOMIC_RELEASE, "agent");
            asm volatile("s_waitcnt vmcnt(0)" ::: "memory");
            const unsigned og = xb_add(&bar[XB_TOP], 1u);
            const unsigned tg = og / nx;
            if (og + 1u == (tg + 1u) * nx) xb_add(&bar[XB_TOPGEN], 1u);
            else XB_SPIN(xb_ld(&bar[XB_TOPGEN]) == tg, bar);
            __builtin_amdgcn_fence(__ATOMIC_ACQUIRE, "agent");
            xb_add(&bar[XB_XGEN(b.x)], 1u);
            asm volatile("s_waitcnt vmcnt(0)" ::: "memory");
        } else {
            XB_SPIN(xb_ld(&bar[XB_XGEN(b.x)]) == gen, bar);
            __builtin_amdgcn_fence(__ATOMIC_ACQUIRE, "agent");
            asm volatile("s_waitcnt vmcnt(0)" ::: "memory");
        }
    }
    __syncthreads();
}

namespace pg8 {
constexpr int BM = 256, BK = 64, HALF = 128, HTB = HALF * BK * 2, NXCD = 8, WGM = 8;
__host__ __device__ __forceinline__ int lds_byte(int r, int c) { const int st = (r >> 4) * 2 + (c >> 5), rr = r & 15, cc = c & 31, ob = rr * 64 + cc * 2; return st * 1024 + (ob ^ (((ob >> 9) & 1) << 5)); }
__host__ __device__ __forceinline__ void stage_rc(int b, int& R, int& C) { const int st = b / 1024, sb = b % 1024, swz = sb ^ (((sb >> 9) & 1) << 5); R = (st >> 1) * 16 + swz / 64; C = (st & 1) * 32 + (swz % 64) / 2; }
__host__ __device__ __forceinline__ int perm32(int rho) { const int n = rho >> 4, i = rho & 15; return 8 * (i >> 2) + 4 * n + (i & 3); }

struct Unit { int pm, pn; };
struct Gemm { const bf16_t* A; const bf16_t* Bt; int M, N, K, lda, ldb, a_pn_off; };

struct StaticOrder {
    int nM, nN, nwg, G, c;
    __host__ __device__ void init(int M, int N, int G_, int c_) { nM = M / BM; nN = N / BM; nwg = nM * nN; G = G_; c = c_; }
    __host__ __device__ bool next(int i, Unit& u) const {
        if (c < 0) return false;
        const long L = (long)i * G + c; if (L >= nwg) return false;
        int wgid = (int)L; { const int q = nwg / NXCD, r = nwg % NXCD, xcd = wgid % NXCD, off = wgid / NXCD; wgid = (xcd < r ? xcd * (q + 1) : r * (q + 1) + (xcd - r) * q) + off; }
        const int nig = WGM * nN, gid = wgid / nig, fm = gid * WGM, gsz = (nM - fm) < WGM ? (nM - fm) : WGM;
        u.pm = fm + ((wgid % nig) % gsz); u.pn = (wgid % nig) / gsz; return true;
    }
};

template <class Epi>
__device__ __forceinline__ void gemm_phase(LAS unsigned char* lds, const Gemm g, const StaticOrder& S, const Epi& E) {
    const int tid = threadIdx.x, wid = __builtin_amdgcn_readfirstlane(tid >> 6), lane = tid & 63, wr = wid >> 2, wc = wid & 3, fr = lane & 15, fq = lane >> 4;
    const int K = g.K, nt = K / BK;
    unsigned voffA[2], voffB[2];
#pragma unroll
    for (int i = 0; i < 2; ++i) { int R, C; stage_rc(tid * 16 + i * 8192, R, C); const int Rb = Epi::PERM ? ((R & ~31) + perm32(R & 31)) : R;
        voffA[i] = (unsigned)(R * g.lda + C) * 2u; voffB[i] = (unsigned)(Rb * g.ldb + C) * 2u; }
    const size_t kstep = (size_t)(BK * 2);
    const size_t hstepA = (size_t)HALF * g.lda * 2, hstepB = (size_t)HALF * g.ldb * 2;
    const size_t tstepA = 2 * hstepA, tstepB = 2 * hstepB;
    const unsigned ldsw = (unsigned)wid * 1024u;
    const int aoff = lds_byte(wr * 64 + fr, fq * 8), boff = lds_byte(wc * 32 + fr, fq * 8);
#define PG8_SA(b, h) (((b) * 2 + (h)) * HTB)
#define PG8_SB(b, h) ((4 + (b) * 2 + (h)) * HTB)
#define PG8_STAGE(bufoff, gbase, voff) do { _Pragma("unroll") for (int _i = 0; _i < 2; ++_i) \
        __builtin_amdgcn_global_load_lds((const unsigned*)((const char*)(gbase) + (voff)[_i]), (LAS unsigned*)(lds + (bufoff) + ldsw + _i * 8192), 16, 0, 0); } while (0)
#define PG8_LDA(dst, b, h) do { _Pragma("unroll") for (int m = 0; m < 4; ++m) _Pragma("unroll") for (int k = 0; k < 2; ++k) dst[m][k] = *(const LAS bf16x8*)(lds + PG8_SA(b, h) + aoff + m * 2048 + k * 1024); } while (0)
#define PG8_LDB(dst, b, h) do { _Pragma("unroll") for (int n = 0; n < 2; ++n) _Pragma("unroll") for (int k = 0; k < 2; ++k) dst[n][k] = *(const LAS bf16x8*)(lds + PG8_SB(b, h) + boff + n * 2048 + k * 1024); } while (0)
#define PG8_MMA(ai, bj, At, Bt) do { __builtin_amdgcn_s_setprio(1); _Pragma("unroll") for (int m = 0; m < 4; ++m) _Pragma("unroll") for (int n = 0; n < 2; ++n) _Pragma("unroll") for (int k = 0; k < 2; ++k) \
        acc[ai][bj][m][n] = __builtin_amdgcn_mfma_f32_16x16x32_bf16(Bt[n][k], At[m][k], acc[ai][bj][m][n], 0, 0, 0); __builtin_amdgcn_s_setprio(0); } while (0)
#define PG8_WAIT_V(n) asm volatile("s_waitcnt vmcnt(" #n ")" ::: "memory")
#define PG8_WAIT_L(n) asm volatile("s_waitcnt lgkmcnt(" #n ")" ::: "memory")
#define PG8_BAR __builtin_amdgcn_s_barrier()
#define PG8_SCHED __builtin_amdgcn_sched_barrier(0)
    Unit cur, nxt; int ui = 0;
    if (!S.next(0, cur)) return;
    f32x4 acc[2][2][4][2];
#pragma unroll
    for (int a = 0; a < 2; ++a)
#pragma unroll
        for (int b = 0; b < 2; ++b)
#pragma unroll
            for (int m = 0; m < 4; ++m)
#pragma unroll
                for (int n = 0; n < 2; ++n) acc[a][b][m][n] = (f32x4){0.f, 0.f, 0.f, 0.f};
    bf16x8 At[4][2], B0[2][2], B1[2][2];
    const char* cA = (const char*)g.A + (size_t)cur.pm * tstepA + (size_t)cur.pn * g.a_pn_off; const char* cB = (const char*)g.Bt + (size_t)cur.pn * tstepB;
    PG8_STAGE(PG8_SB(0, 0), cB, voffB); PG8_STAGE(PG8_SB(0, 1), cB + hstepB, voffB); PG8_STAGE(PG8_SA(0, 0), cA, voffA); PG8_STAGE(PG8_SA(0, 1), cA + hstepA, voffA);
    if (wr == 1) PG8_BAR;
    PG8_WAIT_V(2); PG8_BAR;
    PG8_STAGE(PG8_SB(1, 0), cB + kstep, voffB); PG8_STAGE(PG8_SA(1, 0), cA + kstep, voffA); PG8_STAGE(PG8_SB(1, 1), cB + hstepB + kstep, voffB);
    PG8_WAIT_V(6); PG8_BAR;
    for (;;) {
        const bool has_next = S.next(ui + 1, nxt);
        const char* nA = has_next ? (const char*)g.A + (size_t)nxt.pm * tstepA + (size_t)nxt.pn * g.a_pn_off : cA; const char* nB = has_next ? (const char*)g.Bt + (size_t)nxt.pn * tstepB : cB;
        for (int t = 0; t < nt; t += 2) {
            const bool last = (t == nt - 2);
            const char* a1 = cA + (size_t)(t + 1) * kstep;
            const char* a2 = last ? nA : cA + (size_t)(t + 2) * kstep; const char* b2 = last ? nB : cB + (size_t)(t + 2) * kstep;
            const char* a3 = a2 + kstep; const char* b3 = b2 + kstep;
            PG8_LDB(B0, 0, 0); PG8_LDB(B1, 0, 1); PG8_SCHED; PG8_LDA(At, 0, 0); PG8_STAGE(PG8_SA(1, 1), a1 + hstepA, voffA);
            PG8_WAIT_V(8); PG8_WAIT_L(0); PG8_BAR; PG8_MMA(0, 0, At, B0); PG8_MMA(0, 1, At, B1); PG8_BAR; PG8_SCHED;
            PG8_LDA(At, 0, 1); PG8_STAGE(PG8_SB(0, 0), b2, voffB); PG8_STAGE(PG8_SB(0, 1), b2 + hstepB, voffB); PG8_STAGE(PG8_SA(0, 0), a2, voffA);
            PG8_WAIT_V(8); PG8_WAIT_L(0); PG8_BAR; PG8_MMA(1, 0, At, B0); PG8_MMA(1, 1, At, B1); PG8_BAR; PG8_SCHED;
            PG8_LDB(B0, 1, 0); PG8_LDB(B1, 1, 1); PG8_SCHED; PG8_LDA(At, 1, 0); PG8_STAGE(PG8_SA(0, 1), a2 + hstepA, voffA);
            PG8_WAIT_V(8); PG8_WAIT_L(0); PG8_BAR; PG8_MMA(0, 0, At, B0); PG8_MMA(0, 1, At, B1); PG8_BAR; PG8_SCHED;
            PG8_LDA(At, 1, 1); PG8_STAGE(PG8_SB(1, 0), b3, voffB); PG8_STAGE(PG8_SB(1, 1), b3 + hstepB, voffB); PG8_STAGE(PG8_SA(1, 0), a3, voffA);
            PG8_WAIT_V(8); PG8_WAIT_L(0); PG8_BAR; PG8_MMA(1, 0, At, B0); PG8_MMA(1, 1, At, B1); PG8_BAR; PG8_SCHED;
        }
        if (wr == 0) PG8_BAR;
        E(acc, cur, wr, wc, fr, fq);
        if (!has_next) break;
#pragma unroll
        for (int a = 0; a < 2; ++a)
#pragma unroll
            for (int b = 0; b < 2; ++b)
#pragma unroll
                for (int m = 0; m < 4; ++m)
#pragma unroll
                    for (int n = 0; n < 2; ++n) acc[a][b][m][n] = (f32x4){0.f, 0.f, 0.f, 0.f};
        cur = nxt; cA = nA; cB = nB; ++ui;
        if (wr == 1) PG8_BAR;
    }
    PG8_WAIT_V(0);
    PG8_BAR;
#undef PG8_SA
#undef PG8_SB
#undef PG8_STAGE
#undef PG8_LDA
#undef PG8_LDB
#undef PG8_MMA
#undef PG8_WAIT_V
#undef PG8_WAIT_L
#undef PG8_BAR
#undef PG8_SCHED
}
}

struct EpiProj {
    static constexpr bool PERM = true;
    bf16_t* P; float* logits; const float* rstd;
    __device__ __forceinline__ void operator()(const f32x4 (&acc)[2][2][4][2], const pg8::Unit& u, int wr, int wc, int fr, int fq) const {
        const int row0 = u.pm * 256 + wr * 64 + fr;
        if (u.pn < 20) {
            const int col0 = u.pn * 256 + wc * 32 + 8 * fq;
#pragma unroll
            for (int ai = 0; ai < 2; ++ai)
#pragma unroll
                for (int m = 0; m < 4; ++m) { const int row = row0 + ai * 128 + m * 16; const float rs = rstd[row]; bf16_t* rowp = P + (size_t)row * NPROJ + col0;
#pragma unroll
                    for (int bj = 0; bj < 2; ++bj) { const f32x4 v0 = acc[ai][bj][m][0] * rs, v1 = acc[ai][bj][m][1] * rs;
                        u32x4 w; w.x = pk2(v0[0], v0[1]); w.y = pk2(v0[2], v0[3]); w.z = pk2(v1[0], v1[1]); w.w = pk2(v1[2], v1[3]);
                        *(u32x4*)(rowp + bj * 128) = w; } }
        } else if (wc == 0 && fq < 2) {
#pragma unroll
            for (int ai = 0; ai < 2; ++ai)
#pragma unroll
                for (int m = 0; m < 4; ++m) { const int row = row0 + ai * 128 + m * 16; const float rs = rstd[row]; float* lp = logits + (size_t)row * 16 + 8 * fq;
                    *(f32x4*)lp = acc[ai][0][m][0] * rs; *(f32x4*)(lp + 4) = acc[ai][0][m][1] * rs; }
        }
    }
};
struct EpiBf {
    static constexpr bool PERM = true;
    bf16_t* O; int ldc; int colbase; const float* ssq;
    __device__ __forceinline__ void operator()(const f32x4 (&acc)[2][2][4][2], const pg8::Unit& u, int wr, int wc, int fr, int fq) const {
        const int row0 = u.pm * 256 + wr * 64 + fr; const int col0 = colbase + u.pn * 256 + wc * 32 + 8 * fq;
#pragma unroll
        for (int ai = 0; ai < 2; ++ai)
#pragma unroll
            for (int m = 0; m < 4; ++m) { const int row = row0 + ai * 128 + m * 16; const float rs = ssq ? rsqrtf(ssq[row] * (1.0f / DM) + EPS) : 1.0f; bf16_t* rowp = O + (size_t)row * ldc + col0;
#pragma unroll
                for (int bj = 0; bj < 2; ++bj) { const f32x4 v0 = acc[ai][bj][m][0] * rs, v1 = acc[ai][bj][m][1] * rs;
                    u32x4 w; w.x = pk2(v0[0], v0[1]); w.y = pk2(v0[2], v0[3]); w.z = pk2(v1[0], v1[1]); w.w = pk2(v1[2], v1[3]);
                    *(u32x4*)(rowp + bj * 128) = w; } }
    }
};
struct EpiRes {
    static constexpr bool PERM = false;
    const float* base; float* out; bf16_t* ob; float* ssq;
    __device__ __forceinline__ void operator()(const f32x4 (&acc)[2][2][4][2], const pg8::Unit& u, int wr, int wc, int fr, int fq) const {
        const int row0 = u.pm * 256 + wr * 64 + fr, col0 = u.pn * 256 + wc * 32 + 4 * fq;
#pragma unroll
        for (int ai = 0; ai < 2; ++ai)
#pragma unroll
            for (int m = 0; m < 4; ++m) { const int row = row0 + ai * 128 + m * 16; const size_t off = (size_t)row * DM + col0; float ss = 0.f;
#pragma unroll
                for (int bj = 0; bj < 2; ++bj)
#pragma unroll
                    for (int n = 0; n < 2; ++n) { const f32x4 b = *(const f32x4*)(base + off + bj * 128 + n * 16); const f32x4 v = b + acc[ai][bj][m][n];
                        *(f32x4*)(out + off + bj * 128 + n * 16) = v; ss += (v[0] * v[0] + v[1] * v[1]) + (v[2] * v[2] + v[3] * v[3]);
                        if (ob) { u32x2 w; w.x = pk2(v[0], v[1]); w.y = pk2(v[2], v[3]); *(u32x2*)(ob + off + bj * 128 + n * 16) = w; } }
                ss += __shfl_xor(ss, 16); ss += __shfl_xor(ss, 32);
                if (fq == 0) atomicAdd(ssq + row, ss);
                asm volatile("" ::: "memory"); }
    }
};

struct Params { const float* in[16]; float* out; unsigned char* ws; int ph_lo, ph_hi; };
enum { I_X = 0, I_N1W, I_WIN, I_CONVQ, I_ALOG, I_DTB, I_ONW, I_POOLW, I_POOLS, I_WOUT, I_N2W, I_WUP, I_CONVF, I_CONVFB, I_WDOWN, I_FNW };

__device__ __forceinline__ void tr_item(const float* W, int ldw, int col0, int nvalid, bf16_t* WT, int ldk, int row0, int k0, const float* kscale, const float* nscale, LAS float* scr, int lane) {
    const int n = lane & 31;
#pragma unroll 8
    for (int i = 0; i < 32; ++i) { const int kk = 2 * i + (lane >> 5); float v = (n < nvalid) ? W[(size_t)(k0 + kk) * ldw + col0 + n] : 0.f; if (kscale) v *= kscale[k0 + kk]; scr[kk * 33 + n] = v; }
    asm volatile("s_waitcnt lgkmcnt(0)" ::: "memory");
    const int c = lane & 7;
#pragma unroll
    for (int j = 0; j < 4; ++j) { const int nn = (lane >> 3) + 8 * j; const LAS float* s = scr + (8 * c) * 33 + nn; const float sc = nscale ? nscale[nn] : 1.0f;
        u32x4 o; o.x = pk2(s[0 * 33] * sc, s[1 * 33] * sc); o.y = pk2(s[2 * 33] * sc, s[3 * 33] * sc); o.z = pk2(s[4 * 33] * sc, s[5 * 33] * sc); o.w = pk2(s[6 * 33] * sc, s[7 * 33] * sc);
        *(u32x4*)(WT + (size_t)(row0 + nn) * ldk + k0 + 8 * c) = o; }
    asm volatile("s_waitcnt lgkmcnt(0)" ::: "memory");
}

__device__ __forceinline__ void tr64_item(const float* W, int ldw, int col0, bf16_t* WT, int ldk, int row0, int k0, const float* kscale, const float* nscale, LAS float* scr, int lane) {
    f32x4 v[16];
    const int l15 = lane & 15, lq = lane >> 4;
#pragma unroll
    for (int i = 0; i < 16; ++i) v[i] = *(const f32x4*)(W + (size_t)(k0 + 4 * i + lq) * ldw + col0 + 4 * l15);
    if (kscale) {
#pragma unroll
        for (int i = 0; i < 16; ++i) v[i] = v[i] * kscale[k0 + 4 * i + lq];
    }
#pragma unroll
    for (int i = 0; i < 16; ++i) { LAS float* d = scr + (4 * i + lq) * 65 + 4 * l15; d[0] = v[i][0]; d[1] = v[i][1]; d[2] = v[i][2]; d[3] = v[i][3]; }
    asm volatile("s_waitcnt lgkmcnt(0)" ::: "memory");
    const int c = lane & 7;
#pragma unroll
    for (int j = 0; j < 8; ++j) { const int nn = (lane >> 3) + 8 * j; const LAS float* sp = scr + (8 * c) * 65 + nn; const float sc = nscale ? nscale[nn] : 1.0f;
        u32x4 o; o.x = pk2(sp[0 * 65] * sc, sp[1 * 65] * sc); o.y = pk2(sp[2 * 65] * sc, sp[3 * 65] * sc); o.z = pk2(sp[4 * 65] * sc, sp[5 * 65] * sc); o.w = pk2(sp[6 * 65] * sc, sp[7 * 65] * sc);
        *(u32x4*)(WT + (size_t)(row0 + nn) * ldk + k0 + 8 * c) = o; }
    asm volatile("s_waitcnt lgkmcnt(0)" ::: "memory");
}
__device__ __forceinline__ float wave_sum(float v) {
#pragma unroll
    for (int o = 1; o < 64; o <<= 1) v += __shfl_xor(v, o);
    return v;
}
__device__ __forceinline__ void phase_prep(const Params& p, LAS unsigned char* lds) {
    const int tid = threadIdx.x, lane = tid & 63, wave = tid >> 6;
    const int gw = blockIdx.x * 8 + wave, NGW = gridDim.x * 8;
    unsigned char* ws = p.ws;
    LAS float* scr = (LAS float*)(lds + wave * 16640);
    bf16_t* WinT = (bf16_t*)(ws + OFF_WIN); bf16_t* WoutT = (bf16_t*)(ws + OFF_WOUT); bf16_t* PoolT = (bf16_t*)(ws + OFF_POOLT);
    constexpr int I_A = 32 * 64, I_B = 32 * 16, I_C = 32, I_O = 32 * 32, I_P = 64;
    constexpr int NIT = I_A + I_B + I_C + I_O + I_P;
    for (int it = gw; it < NIT; it += NGW) {
        int r = it;
        if (r < I_A) { const int kb = r / 64, nb = r % 64; tr64_item(p.in[I_WIN], INW, 64 * nb, WinT, DM, 64 * nb, 64 * kb, p.in[I_N1W], nullptr, scr, lane); continue; } r -= I_A;
        if (r < I_B) { const int kb = r / 16, nb = r % 16; tr64_item(p.in[I_WIN], INW, 4112 + 64 * nb, WinT, DM, 4096 + 64 * nb, 64 * kb, p.in[I_N1W], nullptr, scr, lane); continue; } r -= I_B;
        if (r < I_C) { tr_item(p.in[I_WIN], INW, 4096, 16, WinT, DM, 5120, 64 * r, p.in[I_N1W], nullptr, scr, lane); continue; } r -= I_C;
        if (r < I_O) { const int kb = r / 32, nb = r % 32; tr64_item(p.in[I_WOUT], DM, 64 * nb, WoutT, DM, 64 * nb, 64 * kb, nullptr, nullptr, scr, lane); continue; } r -= I_O;
        { const int g = r / 16, kb = (r % 16) / 4, nb = r % 4; tr64_item(p.in[I_POOLW] + (size_t)g * 65536, 256, 64 * nb, PoolT + (size_t)g * 65536, 256, 64 * nb, 64 * kb, nullptr, p.in[I_POOLS] + g * 256 + 64 * nb, scr, lane); }
    }
    { u32x4* z = (u32x4*)(WinT + (size_t)5152 * DM); const int nz = (N1 - 5152) * DM / 8;
      for (int i = blockIdx.x * 512 + tid; i < nz; i += gridDim.x * 512) z[i] = (u32x4){0u, 0u, 0u, 0u}; }
    { float* z = (float*)(ws + OFF_SSQ2); for (int i = blockIdx.x * 512 + tid; i < 2 * MTOK; i += gridDim.x * 512) z[i] = 0.f; }
    bf16_t* XB = (bf16_t*)(ws + OFF_XB); float* rstd1 = (float*)(ws + OFF_RSTD1);
    for (int m = gw; m < MTOK; m += NGW) {
        const f32x4* xr = (const f32x4*)(p.in[I_X] + (size_t)m * DM) + lane; f32x4 v[8]; float s = 0.f;
#pragma unroll
        for (int j = 0; j < 8; ++j) { v[j] = xr[64 * j]; s += (v[j][0] * v[j][0] + v[j][1] * v[j][1]) + (v[j][2] * v[j][2] + v[j][3] * v[j][3]); }
        s = wave_sum(s);
        if (lane == 0) rstd1[m] = rsqrtf(s * (1.0f / DM) + EPS);
        u32x2* o = (u32x2*)(XB + (size_t)m * DM) + lane;
#pragma unroll
        for (int j = 0; j < 8; ++j) { u32x2 w; w.x = pk2(v[j][0], v[j][1]); w.y = pk2(v[j][2], v[j][3]); o[64 * j] = w; }
    }
}


__device__ __forceinline__ void phase_prep2(const Params& p, LAS unsigned char* lds, int vw, int nvw) {
    const int lane = threadIdx.x & 63, wave = threadIdx.x >> 6;
    LAS float* scr = (LAS float*)(lds + wave * 16640);
    bf16_t* WupT = (bf16_t*)(p.ws + OFF_WUP); bf16_t* WdownT = (bf16_t*)(p.ws + OFF_WDOWN);
    constexpr int I_U = 32 * 176, I_D = 88 * 32;
    for (int it = vw; it < I_U + I_D; it += nvw) {
        if (it < I_U) { const int kb = it / 176, nb = it % 176; tr64_item(p.in[I_WUP], NUP, 64 * nb, WupT, DM, 64 * nb, 64 * kb, p.in[I_N2W], nullptr, scr, lane); }
        else { const int r = it - I_U, kb = r / 32, nb = r % 32; tr64_item(p.in[I_WDOWN], DM, 64 * nb, WdownT, DFF, 64 * nb, 64 * kb, nullptr, nullptr, scr, lane); }
    }
}

constexpr int CP_K = 0, CP_V = 33792, CP_L = 67584, CP_QB = 84992, CP_KH = 102400, CP_KL = 119808, CP_MISC = 137216;
__device__ __forceinline__ bf16x8 ld_b128(const LAS unsigned char* p) { return *(const LAS bf16x8*)p; }
__device__ __forceinline__ void chunk_prep(const Params& p, LAS unsigned char* lds, int item) {
    const int tid = threadIdx.x, lane = tid & 63, wave = __builtin_amdgcn_readfirstlane(tid >> 6);
    const int b = item >> 8, h = (item >> 5) & 7, n = item & 31;
    const int t0 = b * SEQ + n * CH, tl0 = n * CH;
    unsigned char* ws = p.ws;
    const bf16_t* proj = (const bf16_t*)(ws + OFF_PROJ);
    const float* logits = (const float*)(ws + OFF_LOGIT);
    unsigned char* cb = ws + OFF_CHUNK + (size_t)item * CHUNK_BYTES;
    float* value_o = (float*)cb; bf16_t* kcum_o = (bf16_t*)(cb + 32768); bf16_t* qg_o = (bf16_t*)(cb + 49152); bf16_t* ktT_o = (bf16_t*)(cb + 65536); bf16_t* qk_o = (bf16_t*)(cb + 81920);
    LAS float* kS = (LAS float*)(lds + CP_K); LAS float* vS = (LAS float*)(lds + CP_V); LAS float* Ls = (LAS float*)(lds + CP_L);
    LAS float* betaS = (LAS float*)(lds + CP_MISC); LAS float* gcS = betaS + 64; LAS float* sclk = betaS + 128; LAS float* egS = betaS + 192; LAS float* etS = betaS + 256;
    const float* cw = p.in[I_CONVQ];
    if (wave == 7) {
        const float lb = logits[(size_t)(t0 + lane) * 16 + h], la = logits[(size_t)(t0 + lane) * 16 + 8 + h];
        const float beta = 1.0f / (1.0f + __expf(-lb));
        const float x = la + p.in[I_DTB][h];
        const float sp = fmaxf(x, 0.f) + log1pf(__expf(-fabsf(x)));
        float g = -__expf(p.in[I_ALOG][h]) * sp;
#pragma unroll
        for (int o = 1; o < 64; o <<= 1) { const float t = __shfl_up(g, o); if (lane >= o) g += t; }
        const float gl = __shfl(g, 63);
        const float eg = __expf(g);
        betaS[lane] = beta; gcS[lane] = g; sclk[lane] = beta * eg; egS[lane] = eg; etS[lane] = __expf(gl - g);
        if (lane == 63) ((float*)(ws + OFF_GLAST))[item] = eg;
    }
#pragma unroll
    for (int kk = 0; kk < 6; ++kk) {
        const int it = tid + 512 * kk;
        const int mat = kk >> 1, r = (it & 1023) >> 4, c = (it & 15) * 8;
        const int col = mat * 1024 + h * HD + c;
        float a[8];
#pragma unroll
        for (int e = 0; e < 8; ++e) a[e] = 0.f;
#pragma unroll
        for (int j = 0; j < 4; ++j) {
            const int dt = r - 3 + j; const bool ok = (tl0 + dt >= 0);
            const u32x4 raw = *(const u32x4*)(proj + (size_t)(t0 + (ok ? dt : 0)) * NPROJ + col);
            const float msk = ok ? 1.0f : 0.0f;
            const f32x4 w0 = *(const f32x4*)(cw + j * 3072 + col) * msk, w1 = *(const f32x4*)(cw + j * 3072 + col + 4) * msk;
            a[0] += w0[0] * bflo(raw.x); a[1] += w0[1] * bfhi(raw.x); a[2] += w0[2] * bflo(raw.y); a[3] += w0[3] * bfhi(raw.y);
            a[4] += w1[0] * bflo(raw.z); a[5] += w1[1] * bfhi(raw.z); a[6] += w1[2] * bflo(raw.w); a[7] += w1[3] * bfhi(raw.w);
        }
#pragma unroll
        for (int e = 0; e < 8; ++e) a[e] = silu_f(a[e]);
        if (mat < 2) {
            float ss = (a[0] * a[0] + a[1] * a[1]) + (a[2] * a[2] + a[3] * a[3]) + (a[4] * a[4] + a[5] * a[5]) + (a[6] * a[6] + a[7] * a[7]);
            ss += __shfl_xor(ss, 1); ss += __shfl_xor(ss, 2); ss += __shfl_xor(ss, 4); ss += __shfl_xor(ss, 8);
            const float sc = rsqrtf(ss + EPS) * (mat == 0 ? 0.08838834764831845f : 1.0f);
#pragma unroll
            for (int e = 0; e < 8; ++e) a[e] *= sc;
        }
        if (mat == 0) {
            u32x4 w; w.x = pk2(a[0], a[1]); w.y = pk2(a[2], a[3]); w.z = pk2(a[4], a[5]); w.w = pk2(a[6], a[7]);
            *(LAS u32x4*)(lds + CP_QB + r * 272 + c * 2) = w;
        } else if (mat == 1) {
            *(LAS f32x4*)(kS + r * 132 + c) = (f32x4){a[0], a[1], a[2], a[3]}; *(LAS f32x4*)(kS + r * 132 + c + 4) = (f32x4){a[4], a[5], a[6], a[7]};
            u32x4 wh; wh.x = pk2(a[0], a[1]); wh.y = pk2(a[2], a[3]); wh.z = pk2(a[4], a[5]); wh.w = pk2(a[6], a[7]);
            u32x4 wl; wl.x = pk2(a[0] - bflo(wh.x), a[1] - bfhi(wh.x)); wl.y = pk2(a[2] - bflo(wh.y), a[3] - bfhi(wh.y)); wl.z = pk2(a[4] - bflo(wh.z), a[5] - bfhi(wh.z)); wl.w = pk2(a[6] - bflo(wh.w), a[7] - bfhi(wh.w));
            *(LAS u32x4*)(lds + CP_KH + r * 272 + c * 2) = wh; *(LAS u32x4*)(lds + CP_KL + r * 272 + c * 2) = wl;
        } else {
            *(LAS f32x4*)(vS + r * 132 + c) = (f32x4){a[0], a[1], a[2], a[3]}; *(LAS f32x4*)(vS + r * 132 + c + 4) = (f32x4){a[4], a[5], a[6], a[7]};
        }
    }
    __syncthreads();
    {
        const int half = wave >> 2, ti = (wave >> 1) & 1, tj = wave & 1, r = lane & 31, hh = lane >> 5;
        f32x16 acc;
#pragma unroll
        for (int e = 0; e < 16; ++e) acc[e] = 0.f;
        if (!(ti == 0 && tj == 1)) {
            const int offA = (32 * ti + r) * 272 + 16 * hh, offB = (32 * tj + r) * 272 + 16 * hh;
#pragma unroll
            for (int ks = 0; ks < 8; ++ks) {
                const bf16x8 bh_ = ld_b128(lds + CP_KH + offB + 32 * ks);
                if (half == 0) {
                    const bf16x8 ah = ld_b128(lds + CP_KH + offA + 32 * ks), al = ld_b128(lds + CP_KL + offA + 32 * ks), bl = ld_b128(lds + CP_KL + offB + 32 * ks);
                    acc = __builtin_amdgcn_mfma_f32_32x32x16_bf16(ah, bh_, acc, 0, 0, 0);
                    acc = __builtin_amdgcn_mfma_f32_32x32x16_bf16(ah, bl, acc, 0, 0, 0);
                    acc = __builtin_amdgcn_mfma_f32_32x32x16_bf16(al, bh_, acc, 0, 0, 0);
                } else {
                    acc = __builtin_amdgcn_mfma_f32_32x32x16_bf16(ld_b128(lds + CP_QB + offA + 32 * ks), bh_, acc, 0, 0, 0);
                }
            }
        }
        const int jj = 32 * tj + r; const float gj = gcS[jj];
#pragma unroll
        for (int i = 0; i < 16; ++i) {
            const int ii = 32 * ti + (i & 3) + 8 * (i >> 2) + 4 * hh;
            const float dec = (ii >= jj) ? __expf(gcS[ii] - gj) : 0.f;
            if (half == 0) Ls[ii * 68 + jj] = (ii > jj) ? betaS[ii] * acc[i] * dec : 0.f;
            else { const unsigned w = pk2(acc[i] * dec, 0.f); qk_o[ii * 64 + jj] = (bf16_t)(w & 0xffffu); }
        }
    }
    __syncthreads();
    if (tid < 256) {
        const int c = tid;
        unsigned msb = (c < 128) ? (unsigned)(CP_V + 4 * c) : (unsigned)(CP_K + 4 * (c - 128)), sclb = (c < 128) ? (unsigned)CP_MISC : (unsigned)(CP_MISC + 512), lsb = CP_L;
        asm volatile("" : "+v"(msb), "+v"(sclb), "+v"(lsb));
        const LAS float* Msrc = (const LAS float*)(lds + msb);
        const LAS float* scl = (const LAS float*)(lds + sclb);
        const LAS float* Lsr = (const LAS float*)(lds + lsb);
        float sol[64];
#pragma unroll
        for (int i = 0; i < 64; ++i) {
            float a = Msrc[i * 132] * scl[i];
#pragma unroll
            for (int j4 = 0; j4 < i; j4 += 4) {
                const f32x4 l = *(const LAS f32x4*)(Lsr + i * 68 + j4);
                a -= l[0] * sol[j4];
                if (j4 + 1 < i) a -= l[1] * sol[j4 + 1];
                if (j4 + 2 < i) a -= l[2] * sol[j4 + 2];
                if (j4 + 3 < i) a -= l[3] * sol[j4 + 3];
            }
            sol[i] = a;
            if (c < 128) value_o[i * 128 + c] = a;
            else { const unsigned w = pk2(-a, 0.f); kcum_o[i * 128 + (c - 128)] = (bf16_t)(w & 0xffffu); }
        }
    } else {
        const int t = tid - 256;
        for (int it = t; it < 1024; it += 256) { const int i = it >> 4, c = (it & 15) * 8; const float e = egS[i];
            const u32x4 q = *(const LAS u32x4*)(lds + CP_QB + i * 272 + c * 2);
            u32x4 w; w.x = pk2(bflo(q.x) * e, bfhi(q.x) * e); w.y = pk2(bflo(q.y) * e, bfhi(q.y) * e); w.z = pk2(bflo(q.z) * e, bfhi(q.z) * e); w.w = pk2(bflo(q.w) * e, bfhi(q.w) * e);
            *(u32x4*)(qg_o + i * 128 + c) = w; }
        for (int it = t; it < 1024; it += 256) { const int d = it & 127, i0 = (it >> 7) * 8; float v[8];
#pragma unroll
            for (int e = 0; e < 8; ++e) v[e] = kS[(i0 + e) * 132 + d] * etS[i0 + e];
            u32x4 w; w.x = pk2(v[0], v[1]); w.y = pk2(v[2], v[3]); w.z = pk2(v[4], v[5]); w.w = pk2(v[6], v[7]);
            *(u32x4*)(ktT_o + d * 64 + i0) = w; }
    }
    __syncthreads();
}
__device__ __forceinline__ void pool_diff(const Params& p) {
    unsigned char* ws = p.ws;
    const bf16_t* proj = (const bf16_t*)(ws + OFF_PROJ); bf16_t* dp = (bf16_t*)(ws + OFF_DPOOL);
    for (int it = blockIdx.x * 512 + threadIdx.x; it < MTOK * 128; it += gridDim.x * 512) {
        const int t = it >> 7, c = (it & 127) * 8, g = c >> 8, w = 2 << g, tl = t & (SEQ - 1);
        const int cnt = (tl + 1 < w) ? tl + 1 : w;
        const bf16_t* src = proj + (size_t)t * NPROJ + 4096 + c;
        float s[8], u0[8];
        { const u32x4 raw = *(const u32x4*)src; u0[0] = bflo(raw.x); u0[1] = bfhi(raw.x); u0[2] = bflo(raw.y); u0[3] = bfhi(raw.y); u0[4] = bflo(raw.z); u0[5] = bfhi(raw.z); u0[6] = bflo(raw.w); u0[7] = bfhi(raw.w); }
#pragma unroll
        for (int e = 0; e < 8; ++e) s[e] = u0[e];
        for (int j = 1; j < cnt; ++j) { const u32x4 raw = *(const u32x4*)(src - (size_t)j * NPROJ);
            s[0] += bflo(raw.x); s[1] += bfhi(raw.x); s[2] += bflo(raw.y); s[3] += bfhi(raw.y); s[4] += bflo(raw.z); s[5] += bfhi(raw.z); s[6] += bflo(raw.w); s[7] += bfhi(raw.w); }
        const float inv = 1.0f / (float)cnt;
        u32x4 o; o.x = pk2(s[0] * inv - u0[0], s[1] * inv - u0[1]); o.y = pk2(s[2] * inv - u0[2], s[3] * inv - u0[3]); o.z = pk2(s[4] * inv - u0[4], s[5] * inv - u0[5]); o.w = pk2(s[6] * inv - u0[6], s[7] * inv - u0[7]);
        *(u32x4*)(dp + (size_t)t * 1024 + c) = o;
    }
}

constexpr int SC_KC = 0, SC_QG = 16896, SC_KT = 33792, SC_QK = 51200, SC_OT = 59904;
__device__ __forceinline__ bf16x8 packh(const f32x16& x, int s) {
    u32x4 r; r.x = pk2(x[8 * s + 0], x[8 * s + 1]); r.y = pk2(x[8 * s + 2], x[8 * s + 3]); r.z = pk2(x[8 * s + 4], x[8 * s + 5]); r.w = pk2(x[8 * s + 6], x[8 * s + 7]);
    return __builtin_bit_cast(bf16x8, r);
}
__device__ __forceinline__ bf16x8 frag_rd(const LAS unsigned char* base, int byteoff) {
    const u32x2 lo = *(const LAS u32x2*)(base + byteoff), hi = *(const LAS u32x2*)(base + byteoff + 16);
    u32x4 r; r.x = lo.x; r.y = lo.y; r.z = hi.x; r.w = hi.y; return __builtin_bit_cast(bf16x8, r);
}
#define SC_BAR() do { asm volatile("s_waitcnt lgkmcnt(0)" ::: "memory"); __builtin_amdgcn_s_barrier(); asm volatile("" ::: "memory"); } while (0)
__device__ __forceinline__ void scan_compute(const Params& p, LAS unsigned char* lds, int bh, int wave, int lane) {
    unsigned char* ws = p.ws;
    const float* glast = (const float*)(ws + OFF_GLAST) + bh * 32;
    const int r = lane & 31, hh = lane >> 5;
    const unsigned char* cb0 = ws + OFF_CHUNK + (size_t)(bh * 32) * CHUNK_BYTES;
    const int voff = (4 * hh) * 128 + 32 * wave + r;
    f32x16 S[4]; bf16x8 Sb[8]; f32x16 vn[2];
#pragma unroll
    for (int i = 0; i < 4; ++i)
#pragma unroll
        for (int e = 0; e < 16; ++e) S[i][e] = 0.f;
#pragma unroll
    for (int i = 0; i < 8; ++i) Sb[i] = (bf16x8){0, 0, 0, 0, 0, 0, 0, 0};
    {
        const float* val = (const float*)cb0 + voff;
#pragma unroll
        for (int mi = 0; mi < 2; ++mi)
#pragma unroll
            for (int i = 0; i < 16; ++i) vn[mi][i] = val[(32 * mi + (i & 3) + 8 * (i >> 2)) * 128];
    }
    SC_BAR();
    for (int n = 0; n < NCH; ++n) {
        LAS float* oT = (LAS float*)(lds + SC_OT + (n & 1) * 33792);
        f32x16 vnx[2];
        {
            const int nn = (n + 1 < NCH) ? n + 1 : n;
            const float* val = (const float*)(cb0 + (size_t)nn * CHUNK_BYTES) + voff;
#pragma unroll
            for (int mi = 0; mi < 2; ++mi)
#pragma unroll
                for (int i = 0; i < 16; ++i) vnx[mi][i] = val[(32 * mi + (i & 3) + 8 * (i >> 2)) * 128];
        }
        const float gl = glast[n];
        f32x16 o[2];
#pragma unroll
        for (int mi = 0; mi < 2; ++mi) {
#pragma unroll
            for (int e = 0; e < 16; ++e) o[mi][e] = 0.f;
#pragma unroll
            for (int ks = 0; ks < 8; ++ks) {
                const int off = (32 * mi + r) * 264 + (16 * ks + 4 * hh) * 2;
                vn[mi] = __builtin_amdgcn_mfma_f32_32x32x16_bf16(frag_rd(lds + SC_KC, off), Sb[ks], vn[mi], 0, 0, 0);
                o[mi] = __builtin_amdgcn_mfma_f32_32x32x16_bf16(frag_rd(lds + SC_QG, off), Sb[ks], o[mi], 0, 0, 0);
            }
        }
        bf16x8 vb[4];
#pragma unroll
        for (int ks = 0; ks < 4; ++ks) vb[ks] = packh(vn[ks >> 1], ks & 1);
#pragma unroll
        for (int mi = 0; mi < 2; ++mi)
#pragma unroll
            for (int ks = 0; ks < 4; ++ks)
                o[mi] = __builtin_amdgcn_mfma_f32_32x32x16_bf16(frag_rd(lds + SC_QK, (32 * mi + r) * 136 + (16 * ks + 4 * hh) * 2), vb[ks], o[mi], 0, 0, 0);
#pragma unroll
        for (int mi = 0; mi < 2; ++mi)
#pragma unroll
            for (int i = 0; i < 16; ++i) oT[(32 * mi + (i & 3) + 8 * (i >> 2) + 4 * hh) * 132 + 32 * wave + r] = o[mi][i];
#pragma unroll
        for (int mt = 0; mt < 4; ++mt) {
            S[mt] = S[mt] * gl;
#pragma unroll
            for (int ks = 0; ks < 4; ++ks)
                S[mt] = __builtin_amdgcn_mfma_f32_32x32x16_bf16(frag_rd(lds + SC_KT, (32 * mt + r) * 136 + (16 * ks + 4 * hh) * 2), vb[ks], S[mt], 0, 0, 0);
            Sb[2 * mt] = packh(S[mt], 0); Sb[2 * mt + 1] = packh(S[mt], 1);
        }
        vn[0] = vnx[0]; vn[1] = vnx[1];
        SC_BAR();
        SC_BAR();
    }
}
__device__ __forceinline__ void scan_finalize(const LAS float* oP, const u32x4 (&zr)[4], const float (&onw)[32], bf16_t* mp) {
    f32x4 v[8]; float ss = 0.f;
#pragma unroll
    for (int e = 0; e < 8; ++e) { v[e] = *(const LAS f32x4*)(oP + 4 * e); ss += (v[e][0] * v[e][0] + v[e][1] * v[e][1]) + (v[e][2] * v[e][2] + v[e][3] * v[e][3]); }
    ss += __shfl_xor(ss, 1); ss += __shfl_xor(ss, 2);
    const float rs = rsqrtf(ss * (1.0f / HD) + EPS);
#pragma unroll
    for (int q = 0; q < 4; ++q) {
        const f32x4 a = v[2 * q] * rs, c2 = v[2 * q + 1] * rs; const u32x4 z = zr[q];
        u32x4 w;
        w.x = pk2(a[0] * onw[8 * q + 0] * silu_f(bflo(z.x)), a[1] * onw[8 * q + 1] * silu_f(bfhi(z.x)));
        w.y = pk2(a[2] * onw[8 * q + 2] * silu_f(bflo(z.y)), a[3] * onw[8 * q + 3] * silu_f(bfhi(z.y)));
        w.z = pk2(c2[0] * onw[8 * q + 4] * silu_f(bflo(z.z)), c2[1] * onw[8 * q + 5] * silu_f(bfhi(z.z)));
        w.w = pk2(c2[2] * onw[8 * q + 6] * silu_f(bflo(z.w)), c2[3] * onw[8 * q + 7] * silu_f(bfhi(z.w)));
        *(u32x4*)(mp + 8 * q) = w;
    }
}
__device__ __forceinline__ void scan_loader(const Params& p, LAS unsigned char* lds, int bh, int lt) {
    unsigned char* ws = p.ws;
    const int b = bh >> 3, h = bh & 7;
    const bf16_t* proj = (const bf16_t*)(ws + OFF_PROJ); bf16_t* mix = (bf16_t*)(ws + OFF_MIX);
    const unsigned char* src0 = ws + OFF_CHUNK + (size_t)(bh * 32) * CHUNK_BYTES + 32768 + lt * 16;
    const int frow = lt >> 2, fpart = lt & 3;
    int sdst[14];
#pragma unroll
    for (int i = 0; i < 14; ++i) {
        int q = lt + 256 * i;
        if (i < 4) sdst[i] = SC_KC + (q >> 4) * 264 + (q & 15) * 16;
        else if (i < 8) { q -= 1024; sdst[i] = SC_QG + (q >> 4) * 264 + (q & 15) * 16; }
        else if (i < 12) { q -= 2048; sdst[i] = SC_KT + (q >> 3) * 136 + (q & 7) * 16; }
        else { q -= 3072; sdst[i] = SC_QK + (q >> 3) * 136 + (q & 7) * 16; }
    }
    float onw[32];
#pragma unroll
    for (int e = 0; e < 32; ++e) onw[e] = p.in[I_ONW][32 * fpart + e];
    u32x4 stg[14];
#pragma unroll
    for (int i = 0; i < 14; ++i) stg[i] = *(const u32x4*)(src0 + i * 4096);
#pragma unroll
    for (int i = 0; i < 14; ++i) { *(LAS u32x2*)(lds + sdst[i]) = (u32x2){stg[i].x, stg[i].y}; *(LAS u32x2*)(lds + sdst[i] + 8) = (u32x2){stg[i].z, stg[i].w}; }
    SC_BAR();
    const bf16_t* zbase = proj + (size_t)(b * SEQ + frow) * NPROJ + 3072 + h * HD + 32 * fpart;
    bf16_t* mbase = mix + (size_t)(b * SEQ + frow) * DM + h * HD + 32 * fpart;
    for (int n = 0; n < NCH; ++n) {
        u32x4 zr[4];
        if (n >= 1) {
#pragma unroll
            for (int q = 0; q < 4; ++q) zr[q] = *(const u32x4*)(zbase + (size_t)(n - 1) * CH * NPROJ + 8 * q);
        }
        {
            const int nn = (n + 1 < NCH) ? n + 1 : n;
#pragma unroll
            for (int i = 0; i < 14; ++i) stg[i] = *(const u32x4*)(src0 + (size_t)nn * CHUNK_BYTES + i * 4096);
        }
        if (n >= 1) scan_finalize((const LAS float*)(lds + SC_OT + ((n - 1) & 1) * 33792) + frow * 132 + 32 * fpart, zr, onw, mbase + (size_t)(n - 1) * CH * DM);
        SC_BAR();
        if (n + 1 < NCH) {
#pragma unroll
            for (int i = 0; i < 14; ++i) { *(LAS u32x2*)(lds + sdst[i]) = (u32x2){stg[i].x, stg[i].y}; *(LAS u32x2*)(lds + sdst[i] + 8) = (u32x2){stg[i].z, stg[i].w}; }
        }
        SC_BAR();
    }
    {
        u32x4 zr[4];
#pragma unroll
        for (int q = 0; q < 4; ++q) zr[q] = *(const u32x4*)(zbase + (size_t)(NCH - 1) * CH * NPROJ + 8 * q);
        scan_finalize((const LAS float*)(lds + SC_OT + ((NCH - 1) & 1) * 33792) + frow * 132 + 32 * fpart, zr, onw, mbase + (size_t)(NCH - 1) * CH * DM);
    }
}
__device__ __forceinline__ void scan_phase(const Params& p, LAS unsigned char* lds, int bh) {
    const int tid = threadIdx.x, wave = __builtin_amdgcn_readfirstlane(tid >> 6);
    if (wave < 4) scan_compute(p, lds, bh, wave, tid & 63);
    else scan_loader(p, lds, bh, tid & 255);
    __syncthreads();
}

__device__ __forceinline__ void act_phase(const Params& p) {
    unsigned char* ws = p.ws;
    const bf16_t* up = (const bf16_t*)(ws + OFF_UP); bf16_t* act = (bf16_t*)(ws + OFF_ACT);
    const float* cw = p.in[I_CONVF]; const float* cbias = p.in[I_CONVFB];
    constexpr int NCG = DFF / 8, RB = 32;
    for (int it = blockIdx.x * 512 + threadIdx.x; it < (MTOK / RB) * NCG; it += gridDim.x * 512) {
        const int cgp = it % NCG, rb = it / NCG, c = cgp * 8, t0 = rb * RB;
        float wg[3][8], wv[3][8], bg[8], bv[8];
#pragma unroll
        for (int j = 0; j < 3; ++j)
#pragma unroll
            for (int e = 0; e < 8; ++e) { wg[j][e] = cw[j * NUP + c + e]; wv[j][e] = cw[j * NUP + DFF + c + e]; }
#pragma unroll
        for (int e = 0; e < 8; ++e) { bg[e] = cbias[c + e]; bv[e] = cbias[DFF + c + e]; }
        float g2[8], g1[8], v2[8], v1[8];
        const bool first = ((t0 & (SEQ - 1)) == 0);
#pragma unroll
        for (int e = 0; e < 8; ++e) { g2[e] = 0.f; g1[e] = 0.f; v2[e] = 0.f; v1[e] = 0.f; }
        if (!first) {
            const u32x4 a = *(const u32x4*)(up + (size_t)(t0 - 2) * NUP + c), b2 = *(const u32x4*)(up + (size_t)(t0 - 1) * NUP + c);
            const u32x4 cc = *(const u32x4*)(up + (size_t)(t0 - 2) * NUP + DFF + c), d = *(const u32x4*)(up + (size_t)(t0 - 1) * NUP + DFF + c);
            g2[0] = bflo(a.x); g2[1] = bfhi(a.x); g2[2] = bflo(a.y); g2[3] = bfhi(a.y); g2[4] = bflo(a.z); g2[5] = bfhi(a.z); g2[6] = bflo(a.w); g2[7] = bfhi(a.w);
            g1[0] = bflo(b2.x); g1[1] = bfhi(b2.x); g1[2] = bflo(b2.y); g1[3] = bfhi(b2.y); g1[4] = bflo(b2.z); g1[5] = bfhi(b2.z); g1[6] = bflo(b2.w); g1[7] = bfhi(b2.w);
            v2[0] = bflo(cc.x); v2[1] = bfhi(cc.x); v2[2] = bflo(cc.y); v2[3] = bfhi(cc.y); v2[4] = bflo(cc.z); v2[5] = bfhi(cc.z); v2[6] = bflo(cc.w); v2[7] = bfhi(cc.w);
            v1[0] = bflo(d.x); v1[1] = bfhi(d.x); v1[2] = bflo(d.y); v1[3] = bfhi(d.y); v1[4] = bflo(d.z); v1[5] = bfhi(d.z); v1[6] = bflo(d.w); v1[7] = bfhi(d.w);
        }
#pragma unroll 4
        for (int rr = 0; rr < RB; ++rr) {
            const int t = t0 + rr;
            const u32x4 a = *(const u32x4*)(up + (size_t)t * NUP + c), d = *(const u32x4*)(up + (size_t)t * NUP + DFF + c);
            float g0[8] = {bflo(a.x), bfhi(a.x), bflo(a.y), bfhi(a.y), bflo(a.z), bfhi(a.z), bflo(a.w), bfhi(a.w)};
            float v0[8] = {bflo(d.x), bfhi(d.x), bflo(d.y), bfhi(d.y), bflo(d.z), bfhi(d.z), bflo(d.w), bfhi(d.w)};
            float o[8];
#pragma unroll
            for (int e = 0; e < 8; ++e) {
                const float G = wg[0][e] * g2[e] + wg[1][e] * g1[e] + wg[2][e] * g0[e] + bg[e];
                const float V = wv[0][e] * v2[e] + wv[1][e] * v1[e] + wv[2][e] * v0[e] + bv[e];
                o[e] = silu_f(G) * V; g2[e] = g1[e]; g1[e] = g0[e]; v2[e] = v1[e]; v1[e] = v0[e];
            }
            u32x4 w; w.x = pk2(o[0], o[1]); w.y = pk2(o[2], o[3]); w.z = pk2(o[4], o[5]); w.w = pk2(o[6], o[7]);
            *(u32x4*)(act + (size_t)t * DFF + c) = w;
        }
    }
}
__device__ __forceinline__ void final_phase(const Params& p) {
    const float* ssq3 = (const float*)(p.ws + OFF_SSQ3); const float* fw = p.in[I_FNW];
    f32x4* o = (f32x4*)p.out;
    for (int i = blockIdx.x * 512 + threadIdx.x; i < MTOK * DM / 4; i += gridDim.x * 512) {
        const int row = i >> 9, c4 = i & 511;
        const float rs = rsqrtf(ssq3[row] * (1.0f / DM) + EPS);
        const f32x4 w = *(const f32x4*)(fw + 4 * c4);
        o[i] = o[i] * rs * w;
    }
}

constexpr int NPHASE = 9;
template <bool COOP>
__global__ void __launch_bounds__(512, 2) mk_fwd(Params p) {
    extern __shared__ __attribute__((aligned(16))) unsigned char lds_raw[];
    LAS unsigned char* lds = (LAS unsigned char*)lds_raw;
    unsigned char* ws = p.ws;
    const int lo = p.ph_lo, hi = p.ph_hi;
    const int G = gridDim.x, bid = blockIdx.x;
#define IN(k) (lo <= (k) && (k) < hi)
#define SEAM(k) do { if (COOP) { if ((k) + 1 < hi) xcd_barrier(bar); } } while (0)
    XcdBarrier bar; bar.bar = (unsigned*)(ws + OFF_BAR); bar.x = 0; bar.st = (volatile LAS unsigned*)(lds + LDS_MISC);
    if (COOP) {
        if (hi > 1000) cg::this_grid().sync();
        if (threadIdx.x < 4) ((LAS unsigned*)(lds + LDS_MISC))[threadIdx.x] = 0u;
        __syncthreads();
        bar = xcd_barrier_post((unsigned*)(ws + OFF_BAR), (volatile LAS unsigned*)(lds + LDS_MISC));
    }
    if (IN(0)) { phase_prep(p, lds); SEAM(0); }
    if (IN(1)) {
        pg8::Gemm g{(const bf16_t*)(ws + OFF_XB), (const bf16_t*)(ws + OFF_WIN), MTOK, N1, DM, DM, DM, 0};
        pg8::StaticOrder S; S.init(MTOK, N1, G, bid);
        EpiProj E{(bf16_t*)(ws + OFF_PROJ), (float*)(ws + OFF_LOGIT), (const float*)(ws + OFF_RSTD1)};
        pg8::gemm_phase<EpiProj>(lds, g, S, E);
        SEAM(1);
    }
    if (IN(2)) {
        for (int item = bid; item < 1024; item += G) chunk_prep(p, lds, item);
        pool_diff(p);
        SEAM(2);
    }
    if (IN(3)) {
        if (bid < 32) scan_phase(p, lds, bid);
        else {
            pg8::Gemm g{(const bf16_t*)(ws + OFF_DPOOL), (const bf16_t*)(ws + OFF_POOLT), MTOK, 1024, 256, 1024, 256, 512};
            pg8::StaticOrder S; S.init(MTOK, 1024, G - 32, bid - 32);
            EpiBf E{(bf16_t*)(ws + OFF_MIX), DM, 1024, nullptr};
            pg8::gemm_phase<EpiBf>(lds, g, S, E);
            phase_prep2(p, lds, (bid - 32) * 8 + (int)(threadIdx.x >> 6), (G - 32) * 8);
        }
        SEAM(3);
    }
    if (IN(4)) {
        pg8::Gemm g{(const bf16_t*)(ws + OFF_MIX), (const bf16_t*)(ws + OFF_WOUT), MTOK, DM, DM, DM, DM, 0};
        pg8::StaticOrder S; S.init(MTOK, DM, G, bid);
        EpiRes E{p.in[I_X], p.out, (bf16_t*)(ws + OFF_XB), (float*)(ws + OFF_SSQ2)};
        pg8::gemm_phase<EpiRes>(lds, g, S, E);
        SEAM(4);
    }
    if (IN(5)) {
        pg8::Gemm g{(const bf16_t*)(ws + OFF_XB), (const bf16_t*)(ws + OFF_WUP), MTOK, NUP, DM, DM, DM, 0};
        pg8::StaticOrder S; S.init(MTOK, NUP, G, bid);
        EpiBf E{(bf16_t*)(ws + OFF_UP), NUP, 0, (const float*)(ws + OFF_SSQ2)};
        pg8::gemm_phase<EpiBf>(lds, g, S, E);
        SEAM(5);
    }
    if (IN(6)) { act_phase(p); SEAM(6); }
    if (IN(7)) {
        pg8::Gemm g{(const bf16_t*)(ws + OFF_ACT), (const bf16_t*)(ws + OFF_WDOWN), MTOK, DM, DFF, DFF, DFF, 0};
        pg8::StaticOrder S; S.init(MTOK, DM, G, bid);
        EpiRes E{p.out, p.out, nullptr, (float*)(ws + OFF_SSQ3)};
        pg8::gemm_phase<EpiRes>(lds, g, S, E);
        SEAM(7);
    }
    if (IN(8)) { final_phase(p); }
#undef IN
#undef SEAM
}

extern "C" void kernel_launch(void* const* d_in, const int* in_sizes, int n_in, void* d_out, int out_size, void* d_ws, size_t ws_size, hipStream_t stream) {
    static int grid = 0;
    if (!grid) {
        if (n_in != 16 || out_size != MTOK * DM || ws_size < WS_END) { fprintf(stderr, "kernel_launch: unexpected shapes (n_in %d out %d ws %zu, need %zu)\n", n_in, out_size, ws_size, (size_t)WS_END); grid = -1; return; }
        int dev = 0, cus = 0, per_cu = 0;
        hipGetDevice(&dev); hipDeviceGetAttribute(&cus, hipDeviceAttributeMultiprocessorCount, dev);
#if ONE_LAUNCH
        hipFuncSetAttribute((const void*)mk_fwd<true>, hipFuncAttributeMaxDynamicSharedMemorySize, LDS_BYTES);
        hipOccupancyMaxActiveBlocksPerMultiprocessor(&per_cu, mk_fwd<true>, 512, LDS_BYTES);
#else
        hipFuncSetAttribute((const void*)mk_fwd<false>, hipFuncAttributeMaxDynamicSharedMemorySize, LDS_BYTES);
        hipOccupancyMaxActiveBlocksPerMultiprocessor(&per_cu, mk_fwd<false>, 512, LDS_BYTES);
#endif
        if (per_cu < 1) per_cu = 1;
        grid = cus * per_cu;
        if (grid < 64) { fprintf(stderr, "kernel_launch: grid %d too small\n", grid); grid = -1; return; }
    }
    if (grid < 0) return;
    Params p{};
    for (int i = 0; i < 16; ++i) p.in[i] = (const float*)d_in[i];
    p.out = (float*)d_out; p.ws = (unsigned char*)d_ws;
#if ONE_LAUNCH
    p.ph_lo = 0; p.ph_hi = NPHASE;
    void* args[] = {&p};
    if (hipMemsetAsync((unsigned char*)d_ws + OFF_BAR, 0, XCD_BAR_WORDS * 4, stream) != hipSuccess) { fprintf(stderr, "kernel_launch: memset failed\n"); return; }
    hipError_t e = hipLaunchCooperativeKernel((const void*)mk_fwd<true>, dim3(grid), dim3(512), args, LDS_BYTES, stream);
    if (e != hipSuccess) fprintf(stderr, "cooperative launch failed: %s (grid %d)\n", hipGetErrorString(e), grid);
#else
    static const int plist[] = {PLIST};
    for (int ph : plist) { p.ph_lo = ph; p.ph_hi = ph + 1; hipLaunchKernelGGL(mk_fwd<false>, dim3(grid), dim3(512), LDS_BYTES, stream, p); }
#endif
}
```

```cpp
#include <hip/hip_runtime.h>
#include <hip/hip_cooperative_groups.h>
#include <cstdio>
#include <cstdint>
namespace cg = cooperative_groups;

#ifndef ONE_LAUNCH
#define ONE_LAUNCH 1
#endif

#ifndef PLIST
#define PLIST 0,1,2,3,4,5,6,7,8
#endif
#define LAS __attribute__((address_space(3)))
typedef unsigned short bf16_t;
typedef short bf16x8 __attribute__((ext_vector_type(8)));
typedef float f32x4 __attribute__((ext_vector_type(4)));
typedef float f32x2 __attribute__((ext_vector_type(2)));
typedef float f32x16 __attribute__((ext_vector_type(16)));
typedef unsigned u32x4 __attribute__((ext_vector_type(4)));
typedef unsigned u32x2 __attribute__((ext_vector_type(2)));
typedef __bf16 bf16x2_t __attribute__((ext_vector_type(2)));

__device__ __forceinline__ unsigned pk2(float lo, float hi) { f32x2 v = {lo, hi}; bf16x2_t r = __builtin_convertvector(v, bf16x2_t); return __builtin_bit_cast(unsigned, r); }
__device__ __forceinline__ float bflo(unsigned w) { return __uint_as_float(w << 16); }
__device__ __forceinline__ float bfhi(unsigned w) { return __uint_as_float(w & 0xffff0000u); }
__device__ __forceinline__ float silu_f(float x) { return x / (1.0f + __expf(-x)); }

constexpr int SEQ = 2048, DM = 2048, MTOK = 8192;
constexpr int NH = 8, HD = 128, CH = 64, NCH = SEQ / CH;
constexpr int DFF = 5632, NUP = 2 * DFF;
constexpr int INW = 5136, NPROJ = 5120, N1 = 5376;
constexpr float EPS = 1e-6f;

constexpr size_t OFF_WIN = 0;
constexpr size_t OFF_WOUT = OFF_WIN + (size_t)N1 * DM * 2;
constexpr size_t OFF_WUP = OFF_WOUT + (size_t)DM * DM * 2;
constexpr size_t OFF_XB = OFF_WUP + (size_t)NUP * DM * 2;
constexpr size_t OFF_ACT = 0;
constexpr size_t OFF_WDOWN = OFF_XB + (size_t)MTOK * DM * 2;
constexpr size_t OFF_POOLT = OFF_WDOWN + (size_t)DM * DFF * 2;
constexpr size_t OFF_LOGIT = OFF_POOLT + 4 * 256 * 256 * 2;
constexpr size_t OFF_RSTD1 = OFF_LOGIT + (size_t)MTOK * 16 * 4;
constexpr size_t OFF_SSQ2 = OFF_RSTD1 + MTOK * 4;
constexpr size_t OFF_SSQ3 = OFF_SSQ2 + MTOK * 4;
constexpr size_t OFF_GLAST = OFF_SSQ3 + MTOK * 4;
constexpr size_t OFF_BAR = OFF_GLAST + 4096;
constexpr size_t OFF_B = ((OFF_BAR + 16384 + 1048575) / 1048576) * 1048576;
constexpr size_t OFF_UP = OFF_B;
constexpr size_t OFF_PROJ = OFF_B;
constexpr size_t CHUNK_BYTES = 16384 * 4 + 8192;
constexpr size_t OFF_CHUNK = OFF_PROJ + (size_t)MTOK * NPROJ * 2;
constexpr size_t OFF_DPOOL = OFF_CHUNK + 1024 * CHUNK_BYTES;
constexpr size_t OFF_MIX = OFF_DPOOL + (size_t)MTOK * 1024 * 2;
constexpr size_t WS_END = OFF_MIX + (size_t)MTOK * DM * 2;
static_assert(OFF_ACT + (size_t)MTOK * DFF * 2 <= OFF_WDOWN, "act overlay");
static_assert(OFF_UP + (size_t)MTOK * NUP * 2 <= WS_END, "up overlay");

constexpr int LDS_BYTES = 147456, LDS_MISC = 147200;
static_assert(WS_END <= 369098752, "workspace budget");


#define XB_TMO      128
#define XB_XCNT(j)  (256  + 64 * (j))
#define XB_XSUB(j)  (1280 + 64 * (j))
#define XB_XGEN(j)  (2304 + 64 * (j))
#define XB_TOP      3328
#define XB_TOPGEN   3392
#define XCD_BAR_WORDS 3456
#define XB_SPIN_CAP (1u << 18)
__device__ __forceinline__ unsigned xb_ld(unsigned* p)              { return __hip_atomic_load(p, __ATOMIC_RELAXED, __HIP_MEMORY_SCOPE_AGENT); }
__device__ __forceinline__ unsigned xb_add(unsigned* p, unsigned v) { return __hip_atomic_fetch_add(p, v, __ATOMIC_RELAXED, __HIP_MEMORY_SCOPE_AGENT); }
__device__ __forceinline__ unsigned xb_xcc_id() { return (unsigned)__builtin_amdgcn_s_getreg((3 << 11) | 20) & 0xFu; }
#define XB_SPIN(cond, bar) do { unsigned _sp = 0; while (cond) { __builtin_amdgcn_s_sleep(1); \
    if ((++_sp & 255u) == 0u) { if (xb_ld(&(bar)[XB_TMO])) break; if (_sp > XB_SPIN_CAP) { atomicAdd(&(bar)[XB_TMO], 1u); break; } } } } while (0)
struct XcdBarrier { unsigned* bar; unsigned x; volatile LAS unsigned* st; };
__device__ __forceinline__ XcdBarrier xcd_barrier_post(unsigned* bar, volatile LAS unsigned* st) {
    XcdBarrier b; b.bar = bar; b.x = xb_xcc_id(); b.st = st;
    if (threadIdx.x == 0) (void)xb_add(&bar[XB_XCNT(b.x)], 1u);
    return b;
}
__device__ __forceinline__ void xcd_barrier_complete(unsigned* bar, unsigned x, unsigned& nloc, unsigned& nx) {
    const unsigned G = gridDim.x * gridDim.y * gridDim.z;
    unsigned sum, cnt, mine, sp = 0u;
    for (;;) {
        sum = 0u; cnt = 0u; mine = 0u;
#pragma unroll
        for (unsigned j = 0; j < 16; ++j) { const unsigned c = xb_ld(&bar[XB_XCNT(j)]); sum += c; cnt += (c > 0u) ? 1u : 0u; mine = (j == x) ? c : mine; }
        if (sum == G) break;
        __builtin_amdgcn_s_sleep(1);
        if ((++sp & 255u) == 0u) { if (xb_ld(&bar[XB_TMO])) break; if (sp > XB_SPIN_CAP) { atomicAdd(&bar[XB_TMO], 1u); break; } }
    }
    nloc = mine > 0u ? mine : 1u; nx = cnt > 0u ? cnt : 1u;
}
__device__ __forceinline__ void xcd_barrier(const XcdBarrier& b) {
    asm volatile("s_waitcnt vmcnt(0)" ::: "memory");
    __syncthreads();
    if (threadIdx.x == 0) {
        unsigned* bar = b.bar;
        __builtin_amdgcn_s_waitcnt(0);
        unsigned nloc = b.st[0], nx = b.st[1];
        if (nloc == 0u) { xcd_barrier_complete(bar, b.x, nloc, nx); b.st[0] = nloc; b.st[1] = nx; }
        const unsigned old = xb_add(&bar[XB_XSUB(b.x)], 1u);
        const unsigned gen = old / nloc;
        if (old + 1u == (gen + 1u) * nloc) {
            __builtin_amdgcn_fence(__ATOMIC_RELEASE, "agent");
            asm volatile("s_waitcnt vmcnt(0)" ::: "memory");
            const unsigned og = xb_add(&bar[XB_TOP], 1u);
            const unsigned tg = og / nx;
            if (og + 1u == (tg + 1u) * nx) xb_add(&bar[XB_TOPGEN], 1u);
            else XB_SPIN(xb_ld(&bar[XB_TOPGEN]) == tg, bar);
            __builtin_amdgcn_fence(__ATOMIC_ACQUIRE, "agent");
            xb_add(&bar[XB_XGEN(b.x)], 1u);
            asm volatile("s_waitcnt vmcnt(0)" ::: "memory");
        } else {
            XB_SPIN(xb_ld(&bar[XB_XGEN(b.x)]) == gen, bar);
            __builtin_amdgcn_fence(__ATOMIC_ACQUIRE, "agent");
            asm volatile("s_waitcnt vmcnt(0)" ::: "memory");
        }
    }
    __syncthreads();
}

namespace pg8 {
constexpr int BM = 256, BK = 64, HALF = 128, HTB = HALF * BK * 2, NXCD = 8, WGM = 8;
__host__ __device__ __forceinline__ int lds_byte(int r, int c) { const int st = (r >> 4) * 2 + (c >> 5), rr = r & 15, cc = c & 31, ob = rr * 64 + cc * 2; return st * 1024 + (ob ^ (((ob >> 9) & 1) << 5)); }
__host__ __device__ __forceinline__ void stage_rc(int b, int& R, int& C) { const int st = b / 1024, sb = b % 1024, swz = sb ^ (((sb >> 9) & 1) << 5); R = (st >> 1) * 16 + swz / 64; C = (st & 1) * 32 + (swz % 64) / 2; }
__host__ __device__ __forceinline__ int perm32(int rho) { const int n = rho >> 4, i = rho & 15; return 8 * (i >> 2) + 4 * n + (i & 3); }

struct Unit { int pm, pn; };
struct Gemm { const bf16_t* A; const bf16_t* Bt; int M, N, K, lda, ldb, a_pn_off; };

struct StaticOrder {
    int nM, nN, nwg, G, c;
    __host__ __device__ void init(int M, int N, int G_, int c_) { nM = M / BM; nN = N / BM; nwg = nM * nN; G = G_; c = c_; }
    __host__ __device__ bool next(int i, Unit& u) const {
        if (c < 0) return false;
        const long L = (long)i * G + c; if (L >= nwg) return false;
        int wgid = (int)L; { const int q = nwg / NXCD, r = nwg % NXCD, xcd = wgid % NXCD, off = wgid / NXCD; wgid = (xcd < r ? xcd * (q + 1) : r * (q + 1) + (xcd - r) * q) + off; }
        const int nig = WGM * nN, gid = wgid / nig, fm = gid * WGM, gsz = (nM - fm) < WGM ? (nM - fm) : WGM;
        u.pm = fm + ((wgid % nig) % gsz); u.pn = (wgid % nig) / gsz; return true;
    }
};

template <class Epi>
__device__ __forceinline__ void gemm_phase(LAS unsigned char* lds, const Gemm g, const StaticOrder& S, const Epi& E) {
    const int tid = threadIdx.x, wid = __builtin_amdgcn_readfirstlane(tid >> 6), lane = tid & 63, wr = wid >> 2, wc = wid & 3, fr = lane & 15, fq = lane >> 4;
    const int K = g.K, nt = K / BK;
    unsigned voffA[2], voffB[2];
#pragma unroll
    for (int i = 0; i < 2; ++i) { int R, C; stage_rc(tid * 16 + i * 8192, R, C); const int Rb = Epi::PERM ? ((R & ~31) + perm32(R & 31)) : R;
        voffA[i] = (unsigned)(R * g.lda + C) * 2u; voffB[i] = (unsigned)(Rb * g.ldb + C) * 2u; }
    const size_t kstep = (size_t)(BK * 2);
    const size_t hstepA = (size_t)HALF * g.lda * 2, hstepB = (size_t)HALF * g.ldb * 2;
    const size_t tstepA = 2 * hstepA, tstepB = 2 * hstepB;
    const unsigned ldsw = (unsigned)wid * 1024u;
    const int aoff = lds_byte(wr * 64 + fr, fq * 8), boff = lds_byte(wc * 32 + fr, fq * 8);
#define PG8_SA(b, h) (((b) * 2 + (h)) * HTB)
#define PG8_SB(b, h) ((4 + (b) * 2 + (h)) * HTB)
#define PG8_STAGE(bufoff, gbase, voff) do { _Pragma("unroll") for (int _i = 0; _i < 2; ++_i) \
        __builtin_amdgcn_global_load_lds((const unsigned*)((const char*)(gbase) + (voff)[_i]), (LAS unsigned*)(lds + (bufoff) + ldsw + _i * 8192), 16, 0, 0); } while (0)
#define PG8_LDA(dst, b, h) do { _Pragma("unroll") for (int m = 0; m < 4; ++m) _Pragma("unroll") for (int k = 0; k < 2; ++k) dst[m][k] = *(const LAS bf16x8*)(lds + PG8_SA(b, h) + aoff + m * 2048 + k * 1024); } while (0)
#define PG8_LDB(dst, b, h) do { _Pragma("unroll") for (int n = 0; n < 2; ++n) _Pragma("unroll") for (int k = 0; k < 2; ++k) dst[n][k] = *(const LAS bf16x8*)(lds + PG8_SB(b, h) + boff + n * 2048 + k * 1024); } while (0)
#define PG8_MMA(ai, bj, At, Bt) do { __builtin_amdgcn_s_setprio(1); _Pragma("unroll") for (int m = 0; m < 4; ++m) _Pragma("unroll") for (int n = 0; n < 2; ++n) _Pragma("unroll") for (int k = 0; k < 2; ++k) \
        acc[ai][bj][m][n] = __builtin_amdgcn_mfma_f32_16x16x32_bf16(Bt[n][k], At[m][k], acc[ai][bj][m][n], 0, 0, 0); __builtin_amdgcn_s_setprio(0); } while (0)
#define PG8_WAIT_V(n) asm volatile("s_waitcnt vmcnt(" #n ")" ::: "memory")
#define PG8_WAIT_L(n) asm volatile("s_waitcnt lgkmcnt(" #n ")" ::: "memory")
#define PG8_BAR __builtin_amdgcn_s_barrier()
#define PG8_SCHED __builtin_amdgcn_sched_barrier(0)
    Unit cur, nxt; int ui = 0;
    if (!S.next(0, cur)) return;
    f32x4 acc[2][2][4][2];
#pragma unroll
    for (int a = 0; a < 2; ++a)
#pragma unroll
        for (int b = 0; b < 2; ++b)
#pragma unroll
            for (int m = 0; m < 4; ++m)
#pragma unroll
                for (int n = 0; n < 2; ++n) acc[a][b][m][n] = (f32x4){0.f, 0.f, 0.f, 0.f};
    bf16x8 At[4][2], B0[2][2], B1[2][2];
    const char* cA = (const char*)g.A + (size_t)cur.pm * tstepA + (size_t)cur.pn * g.a_pn_off; const char* cB = (const char*)g.Bt + (size_t)cur.pn * tstepB;
    PG8_STAGE(PG8_SB(0, 0), cB, voffB); PG8_STAGE(PG8_SB(0, 1), cB + hstepB, voffB); PG8_STAGE(PG8_SA(0, 0), cA, voffA); PG8_STAGE(PG8_SA(0, 1), cA + hstepA, voffA);
    if (wr == 1) PG8_BAR;
    PG8_WAIT_V(2); PG8_BAR;
    PG8_STAGE(PG8_SB(1, 0), cB + kstep, voffB); PG8_STAGE(PG8_SA(1, 0), cA + kstep, voffA); PG8_STAGE(PG8_SB(1, 1), cB + hstepB + kstep, voffB);
    PG8_WAIT_V(6); PG8_BAR;
    for (;;) {
        const bool has_next = S.next(ui + 1, nxt);
        const char* nA = has_next ? (const char*)g.A + (size_t)nxt.pm * tstepA + (size_t)nxt.pn * g.a_pn_off : cA; const char* nB = has_next ? (const char*)g.Bt + (size_t)nxt.pn * tstepB : cB;
        for (int t = 0; t < nt; t += 2) {
            const bool last = (t == nt - 2);
            const char* a1 = cA + (size_t)(t + 1) * kstep;
            const char* a2 = last ? nA : cA + (size_t)(t + 2) * kstep; const char* b2 = last ? nB : cB + (size_t)(t + 2) * kstep;
            const char* a3 = a2 + kstep; const char* b3 = b2 + kstep;
            PG8_LDB(B0, 0, 0); PG8_LDB(B1, 0, 1); PG8_SCHED; PG8_LDA(At, 0, 0); PG8_STAGE(PG8_SA(1, 1), a1 + hstepA, voffA);
            PG8_WAIT_V(8); PG8_WAIT_L(0); PG8_BAR; PG8_MMA(0, 0, At, B0); PG8_MMA(0, 1, At, B1); PG8_BAR; PG8_SCHED;
            PG8_LDA(At, 0, 1); PG8_STAGE(PG8_SB(0, 0), b2, voffB); PG8_STAGE(PG8_SB(0, 1), b2 + hstepB, voffB); PG8_STAGE(PG8_SA(0, 0), a2, voffA);
            PG8_WAIT_V(8); PG8_WAIT_L(0); PG8_BAR; PG8_MMA(1, 0, At, B0); PG8_MMA(1, 1, At, B1); PG8_BAR; PG8_SCHED;
            PG8_LDB(B0, 1, 0); PG8_LDB(B1, 1, 1); PG8_SCHED; PG8_LDA(At, 1, 0); PG8_STAGE(PG8_SA(0, 1), a2 + hstepA, voffA);
            PG8_WAIT_V(8); PG8_WAIT_L(0); PG8_BAR; PG8_MMA(0, 0, At, B0); PG8_MMA(0, 1, At, B1); PG8_BAR; PG8_SCHED;
            PG8_LDA(At, 1, 1); PG8_STAGE(PG8_SB(1, 0), b3, voffB); PG8_STAGE(PG8_SB(1, 1), b3 + hstepB, voffB); PG8_STAGE(PG8_SA(1, 0), a3, voffA);
            PG8_WAIT_V(8); PG8_WAIT_L(0); PG8_BAR; PG8_MMA(1, 0, At, B0); PG8_MMA(1, 1, At, B1); PG8_BAR; PG8_SCHED;
        }
        if (wr == 0) PG8_BAR;
        E(acc, cur, wr, wc, fr, fq);
        if (!has_next) break;
#pragma unroll
        for (int a = 0; a < 2; ++a)
#pragma unroll
            for (int b = 0; b < 2; ++b)
#pragma unroll
                for (int m = 0; m < 4; ++m)
#pragma unroll
                    for (int n = 0; n < 2; ++n) acc[a][b][m][n] = (f32x4){0.f, 0.f, 0.f, 0.f};
        cur = nxt; cA = nA; cB = nB; ++ui;
        if (wr == 1) PG8_BAR;
    }
    PG8_WAIT_V(0);
    PG8_BAR;
#undef PG8_SA
#undef PG8_SB
#undef PG8_STAGE
#undef PG8_LDA
#undef PG8_LDB
#undef PG8_MMA
#undef PG8_WAIT_V
#undef PG8_WAIT_L
#undef PG8_BAR
#undef PG8_SCHED
}
}

struct EpiProj {
    static constexpr bool PERM = true;
    bf16_t* P; float* logits; const float* rstd;
    __device__ __forceinline__ void operator()(const f32x4 (&acc)[2][2][4][2], const pg8::Unit& u, int wr, int wc, int fr, int fq) const {
        const int row0 = u.pm * 256 + wr * 64 + fr;
        if (u.pn < 20) {
            const int col0 = u.pn * 256 + wc * 32 + 8 * fq;
#pragma unroll
            for (int ai = 0; ai < 2; ++ai)
#pragma unroll
                for (int m = 0; m < 4; ++m) { const int row = row0 + ai * 128 + m * 16; const float rs = rstd[row]; bf16_t* rowp = P + (size_t)row * NPROJ + col0;
#pragma unroll
                    for (int bj = 0; bj < 2; ++bj) { const f32x4 v0 = acc[ai][bj][m][0] * rs, v1 = acc[ai][bj][m][1] * rs;
                        u32x4 w; w.x = pk2(v0[0], v0[1]); w.y = pk2(v0[2], v0[3]); w.z = pk2(v1[0], v1[1]); w.w = pk2(v1[2], v1[3]);
                        *(u32x4*)(rowp + bj * 128) = w; } }
        } else if (wc == 0 && fq < 2) {
#pragma unroll
            for (int ai = 0; ai < 2; ++ai)
#pragma unroll
                for (int m = 0; m < 4; ++m) { const int row = row0 + ai * 128 + m * 16; const float rs = rstd[row]; float* lp = logits + (size_t)row * 16 + 8 * fq;
                    *(f32x4*)lp = acc[ai][0][m][0] * rs; *(f32x4*)(lp + 4) = acc[ai][0][m][1] * rs; }
        }
    }
};
struct EpiBf {
    static constexpr bool PERM = true;
    bf16_t* O; int ldc; int colbase; const float* ssq;
    __device__ __forceinline__ void operator()(const f32x4 (&acc)[2][2][4][2], const pg8::Unit& u, int wr, int wc, int fr, int fq) const {
        const int row0 = u.pm * 256 + wr * 64 + fr; const int col0 = colbase + u.pn * 256 + wc * 32 + 8 * fq;
#pragma unroll
        for (int ai = 0; ai < 2; ++ai)
#pragma unroll
            for (int m = 0; m < 4; ++m) { const int row = row0 + ai * 128 + m * 16; const float rs = ssq ? rsqrtf(ssq[row] * (1.0f / DM) + EPS) : 1.0f; bf16_t* rowp = O + (size_t)row * ldc + col0;
#pragma unroll
                for (int bj = 0; bj < 2; ++bj) { const f32x4 v0 = acc[ai][bj][m][0] * rs, v1 = acc[ai][bj][m][1] * rs;
                    u32x4 w; w.x = pk2(v0[0], v0[1]); w.y = pk2(v0[2], v0[3]); w.z = pk2(v1[0], v1[1]); w.w = pk2(v1[2], v1[3]);
                    *(u32x4*)(rowp + bj * 128) = w; } }
    }
};
struct EpiRes {
    static constexpr bool PERM = false;
    const float* base; float* out; bf16_t* ob; float* ssq;
    __device__ __forceinline__ void operator()(const f32x4 (&acc)[2][2][4][2], const pg8::Unit& u, int wr, int wc, int fr, int fq) const {
        const int row0 = u.pm * 256 + wr * 64 + fr, col0 = u.pn * 256 + wc * 32 + 4 * fq;
#pragma unroll
        for (int ai = 0; ai < 2; ++ai)
#pragma unroll
            for (int m = 0; m < 4; ++m) { const int row = row0 + ai * 128 + m * 16; const size_t off = (size_t)row * DM + col0; float ss = 0.f;
#pragma unroll
                for (int bj = 0; bj < 2; ++bj)
#pragma unroll
                    for (int n = 0; n < 2; ++n) { const f32x4 b = *(const f32x4*)(base + off + bj * 128 + n * 16); const f32x4 v = b + acc[ai][bj][m][n];
                        *(f32x4*)(out + off + bj * 128 + n * 16) = v; ss += (v[0] * v[0] + v[1] * v[1]) + (v[2] * v[2] + v[3] * v[3]);
                        if (ob) { u32x2 w; w.x = pk2(v[0], v[1]); w.y = pk2(v[2], v[3]); *(u32x2*)(ob + off + bj * 128 + n * 16) = w; } }
                ss += __shfl_xor(ss, 16); ss += __shfl_xor(ss, 32);
                if (fq == 0) atomicAdd(ssq + row, ss);
                asm volatile("" ::: "memory"); }
    }
};

struct Params { const float* in[16]; float* out; unsigned char* ws; int ph_lo, ph_hi; };
enum { I_X = 0, I_N1W, I_WIN, I_CONVQ, I_ALOG, I_DTB, I_ONW, I_POOLW, I_POOLS, I_WOUT, I_N2W, I_WUP, I_CONVF, I_CONVFB, I_WDOWN, I_FNW };

__device__ __forceinline__ void tr_item(const float* W, int ldw, int col0, int nvalid, bf16_t* WT, int ldk, int row0, int k0, const float* kscale, const float* nscale, LAS float* scr, int lane) {
    const int n = lane & 31;
#pragma unroll 8
    for (int i = 0; i < 32; ++i) { const int kk = 2 * i + (lane >> 5); float v = (n < nvalid) ? W[(size_t)(k0 + kk) * ldw + col0 + n] : 0.f; if (kscale) v *= kscale[k0 + kk]; scr[kk * 33 + n] = v; }
    asm volatile("s_waitcnt lgkmcnt(0)" ::: "memory");
    const int c = lane & 7;
#pragma unroll
    for (int j = 0; j < 4; ++j) { const int nn = (lane >> 3) + 8 * j; const LAS float* s = scr + (8 * c) * 33 + nn; const float sc = nscale ? nscale[nn] : 1.0f;
        u32x4 o; o.x = pk2(s[0 * 33] * sc, s[1 * 33] * sc); o.y = pk2(s[2 * 33] * sc, s[3 * 33] * sc); o.z = pk2(s[4 * 33] * sc, s[5 * 33] * sc); o.w = pk2(s[6 * 33] * sc, s[7 * 33] * sc);
        *(u32x4*)(WT + (size_t)(row0 + nn) * ldk + k0 + 8 * c) = o; }
    asm volatile("s_waitcnt lgkmcnt(0)" ::: "memory");
}

__device__ __forceinline__ void tr64_item(const float* W, int ldw, int col0, bf16_t* WT, int ldk, int row0, int k0, const float* kscale, const float* nscale, LAS float* scr, int lane) {
    f32x4 v[16];
    const int l15 = lane & 15, lq = lane >> 4;
#pragma unroll
    for (int i = 0; i < 16; ++i) v[i] = *(const f32x4*)(W + (size_t)(k0 + 4 * i + lq) * ldw + col0 + 4 * l15);
    if (kscale) {
#pragma unroll
        for (int i = 0; i < 16; ++i) v[i] = v[i] * kscale[k0 + 4 * i + lq];
    }
#pragma unroll
    for (int i = 0; i < 16; ++i) { LAS float* d = scr + (4 * i + lq) * 65 + 4 * l15; d[0] = v[i][0]; d[1] = v[i][1]; d[2] = v[i][2]; d[3] = v[i][3]; }
    asm volatile("s_waitcnt lgkmcnt(0)" ::: "memory");
    const int c = lane & 7;
#pragma unroll
    for (int j = 0; j < 8; ++j) { const int nn = (lane >> 3) + 8 * j; const LAS float* sp = scr + (8 * c) * 65 + nn; const float sc = nscale ? nscale[nn] : 1.0f;
        u32x4 o; o.x = pk2(sp[0 * 65] * sc, sp[1 * 65] * sc); o.y = pk2(sp[2 * 65] * sc, sp[3 * 65] * sc); o.z = pk2(sp[4 * 65] * sc, sp[5 * 65] * sc); o.w = pk2(sp[6 * 65] * sc, sp[7 * 65] * sc);
        *(u32x4*)(WT + (size_t)(row0 + nn) * ldk + k0 + 8 * c) = o; }
    asm volatile("s_waitcnt lgkmcnt(0)" ::: "memory");
}
__device__ __forceinline__ float wave_sum(float v) {
#pragma unroll
    for (int o = 1; o < 64; o <<= 1) v += __shfl_xor(v, o);
    return v;
}
__device__ __forceinline__ void phase_prep(const Params& p, LAS unsigned char* lds) {
    const int tid = threadIdx.x, lane = tid & 63, wave = tid >> 6;
    const int gw = blockIdx.x * 8 + wave, NGW = gridDim.x * 8;
    unsigned char* ws = p.ws;
    LAS float* scr = (LAS float*)(lds + wave * 16640);
    bf16_t* WinT = (bf16_t*)(ws + OFF_WIN); bf16_t* WoutT = (bf16_t*)(ws + OFF_WOUT); bf16_t* PoolT = (bf16_t*)(ws + OFF_POOLT);
    constexpr int I_A = 32 * 64, I_B = 32 * 16, I_C = 32, I_O = 32 * 32, I_P = 64;
    constexpr int NIT = I_A + I_B + I_C + I_O + I_P;
    for (int it = gw; it < NIT; it += NGW) {
        int r = it;
        if (r < I_A) { const int kb = r / 64, nb = r % 64; tr64_item(p.in[I_WIN], INW, 64 * nb, WinT, DM, 64 * nb, 64 * kb, p.in[I_N1W], nullptr, scr, lane); continue; } r -= I_A;
        if (r < I_B) { const int kb = r / 16, nb = r % 16; tr64_item(p.in[I_WIN], INW, 4112 + 64 * nb, WinT, DM, 4096 + 64 * nb, 64 * kb, p.in[I_N1W], nullptr, scr, lane); continue; } r -= I_B;
        if (r < I_C) { tr_item(p.in[I_WIN], INW, 4096, 16, WinT, DM, 5120, 64 * r, p.in[I_N1W], nullptr, scr, lane); continue; } r -= I_C;
        if (r < I_O) { const int kb = r / 32, nb = r % 32; tr64_item(p.in[I_WOUT], DM, 64 * nb, WoutT, DM, 64 * nb, 64 * kb, nullptr, nullptr, scr, lane); continue; } r -= I_O;
        { const int g = r / 16, kb = (r % 16) / 4, nb = r % 4; tr64_item(p.in[I_POOLW] + (size_t)g * 65536, 256, 64 * nb, PoolT + (size_t)g * 65536, 256, 64 * nb, 64 * kb, nullptr, p.in[I_POOLS] + g * 256 + 64 * nb, scr, lane); }
    }
    { u32x4* z = (u32x4*)(WinT + (size_t)5152 * DM); const int nz = (N1 - 5152) * DM / 8;
      for (int i = blockIdx.x * 512 + tid; i < nz; i += gridDim.x * 512) z[i] = (u32x4){0u, 0u, 0u, 0u}; }
    { float* z = (float*)(ws + OFF_SSQ2); for (int i = blockIdx.x * 512 + tid; i < 2 * MTOK; i += gridDim.x * 512) z[i] = 0.f; }
    bf16_t* XB = (bf16_t*)(ws + OFF_XB); float* rstd1 = (float*)(ws + OFF_RSTD1);
    for (int m = gw; m < MTOK; m += NGW) {
        const f32x4* xr = (const f32x4*)(p.in[I_X] + (size_t)m * DM) + lane; f32x4 v[8]; float s = 0.f;
#pragma unroll
        for (int j = 0; j < 8; ++j) { v[j] = xr[64 * j]; s += (v[j][0] * v[j][0] + v[j][1] * v[j][1]) + (v[j][2] * v[j][2] + v[j][3] * v[j][3]); }
        s = wave_sum(s);
        if (lane == 0) rstd1[m] = rsqrtf(s * (1.0f / DM) + EPS);
        u32x2* o = (u32x2*)(XB + (size_t)m * DM) + lane;
#pragma unroll
        for (int j = 0; j < 8; ++j) { u32x2 w; w.x = pk2(v[j][0], v[j][1]); w.y = pk2(v[j][2], v[j][3]); o[64 * j] = w; }
    }
}


__device__ __forceinline__ void phase_prep2(const Params& p, LAS unsigned char* lds, int vw, int nvw) {
    const int lane = threadIdx.x & 63, wave = threadIdx.x >> 6;
    LAS float* scr = (LAS float*)(lds + wave * 16640);
    bf16_t* WupT = (bf16_t*)(p.ws + OFF_WUP); bf16_t* WdownT = (bf16_t*)(p.ws + OFF_WDOWN);
    constexpr int I_U = 32 * 176, I_D = 88 * 32;
    for (int it = vw; it < I_U + I_D; it += nvw) {
        if (it < I_U) { const int kb = it / 176, nb = it % 176; tr64_item(p.in[I_WUP], NUP, 64 * nb, WupT, DM, 64 * nb, 64 * kb, p.in[I_N2W], nullptr, scr, lane); }
        else { const int r = it - I_U, kb = r / 32, nb = r % 32; tr64_item(p.in[I_WDOWN], DM, 64 * nb, WdownT, DFF, 64 * nb, 64 * kb, nullptr, nullptr, scr, lane); }
    }
}

constexpr int CP_K = 0, CP_V = 33792, CP_L = 67584, CP_QB = 84992, CP_KH = 102400, CP_KL = 119808, CP_MISC = 137216;
__device__ __forceinline__ bf16x8 ld_b128(const LAS unsigned char* p) { return *(const LAS bf16x8*)p; }
__device__ __forceinline__ void chunk_prep(const Params& p, LAS unsigned char* lds, int item) {
    const int tid = threadIdx.x, lane = tid & 63, wave = __builtin_amdgcn_readfirstlane(tid >> 6);
    const int b = item >> 8, h = (item >> 5) & 7, n = item & 31;
    const int t0 = b * SEQ + n * CH, tl0 = n * CH;
    unsigned char* ws = p.ws;
    const bf16_t* proj = (const bf16_t*)(ws + OFF_PROJ);
    const float* logits = (const float*)(ws + OFF_LOGIT);
    unsigned char* cb = ws + OFF_CHUNK + (size_t)item * CHUNK_BYTES;
    bf16_t* valT_o = (bf16_t*)cb; bf16_t* kcum_o = (bf16_t*)(cb + 16384); bf16_t* qg_o = (bf16_t*)(cb + 32768); bf16_t* ktT_o = (bf16_t*)(cb + 49152); bf16_t* qk_o = (bf16_t*)(cb + 65536);
    LAS float* kS = (LAS float*)(lds + CP_K); LAS float* vS = (LAS float*)(lds + CP_V); LAS float* Ls = (LAS float*)(lds + CP_L);
    LAS float* betaS = (LAS float*)(lds + CP_MISC); LAS float* gcS = betaS + 64; LAS float* sclk = betaS + 128; LAS float* egS = betaS + 192; LAS float* etS = betaS + 256;
    const float* cw = p.in[I_CONVQ];
    if (wave == 7) {
        const float lb = logits[(size_t)(t0 + lane) * 16 + h], la = logits[(size_t)(t0 + lane) * 16 + 8 + h];
        const float beta = 1.0f / (1.0f + __expf(-lb));
        const float x = la + p.in[I_DTB][h];
        const float sp = fmaxf(x, 0.f) + log1pf(__expf(-fabsf(x)));
        float g = -__expf(p.in[I_ALOG][h]) * sp;
#pragma unroll
        for (int o = 1; o < 64; o <<= 1) { const float t = __shfl_up(g, o); if (lane >= o) g += t; }
        const float gl = __shfl(g, 63);
        const float eg = __expf(g);
        betaS[lane] = beta; gcS[lane] = g; sclk[lane] = beta * eg; egS[lane] = eg; etS[lane] = __expf(gl - g);
        if (lane == 63) ((float*)(ws + OFF_GLAST))[item] = eg;
    }
#pragma unroll
    for (int kk = 0; kk < 6; ++kk) {
        const int it = tid + 512 * kk;
        const int mat = kk >> 1, r = (it & 1023) >> 4, c = (it & 15) * 8;
        const int col = mat * 1024 + h * HD + c;
        float a[8];
#pragma unroll
        for (int e = 0; e < 8; ++e) a[e] = 0.f;
#pragma unroll
        for (int j = 0; j < 4; ++j) {
            const int dt = r - 3 + j; const bool ok = (tl0 + dt >= 0);
            const u32x4 raw = *(const u32x4*)(proj + (size_t)(t0 + (ok ? dt : 0)) * NPROJ + col);
            const float msk = ok ? 1.0f : 0.0f;
            const f32x4 w0 = *(const f32x4*)(cw + j * 3072 + col) * msk, w1 = *(const f32x4*)(cw + j * 3072 + col + 4) * msk;
            a[0] += w0[0] * bflo(raw.x); a[1] += w0[1] * bfhi(raw.x); a[2] += w0[2] * bflo(raw.y); a[3] += w0[3] * bfhi(raw.y);
            a[4] += w1[0] * bflo(raw.z); a[5] += w1[1] * bfhi(raw.z); a[6] += w1[2] * bflo(raw.w); a[7] += w1[3] * bfhi(raw.w);
        }
#pragma unroll
        for (int e = 0; e < 8; ++e) a[e] = silu_f(a[e]);
        if (mat < 2) {
            float ss = (a[0] * a[0] + a[1] * a[1]) + (a[2] * a[2] + a[3] * a[3]) + (a[4] * a[4] + a[5] * a[5]) + (a[6] * a[6] + a[7] * a[7]);
            ss += __shfl_xor(ss, 1); ss += __shfl_xor(ss, 2); ss += __shfl_xor(ss, 4); ss += __shfl_xor(ss, 8);
            const float sc = rsqrtf(ss + EPS) * (mat == 0 ? 0.08838834764831845f : 1.0f);
#pragma unroll
            for (int e = 0; e < 8; ++e) a[e] *= sc;
        }
        if (mat == 0) {
            u32x4 w; w.x = pk2(a[0], a[1]); w.y = pk2(a[2], a[3]); w.z = pk2(a[4], a[5]); w.w = pk2(a[6], a[7]);
            *(LAS u32x4*)(lds + CP_QB + r * 272 + c * 2) = w;
        } else if (mat == 1) {
            *(LAS f32x4*)(kS + r * 132 + c) = (f32x4){a[0], a[1], a[2], a[3]}; *(LAS f32x4*)(kS + r * 132 + c + 4) = (f32x4){a[4], a[5], a[6], a[7]};
            u32x4 wh; wh.x = pk2(a[0], a[1]); wh.y = pk2(a[2], a[3]); wh.z = pk2(a[4], a[5]); wh.w = pk2(a[6], a[7]);
            u32x4 wl; wl.x = pk2(a[0] - bflo(wh.x), a[1] - bfhi(wh.x)); wl.y = pk2(a[2] - bflo(wh.y), a[3] - bfhi(wh.y)); wl.z = pk2(a[4] - bflo(wh.z), a[5] - bfhi(wh.z)); wl.w = pk2(a[6] - bflo(wh.w), a[7] - bfhi(wh.w));
            *(LAS u32x4*)(lds + CP_KH + r * 272 + c * 2) = wh; *(LAS u32x4*)(lds + CP_KL + r * 272 + c * 2) = wl;
        } else {
            *(LAS f32x4*)(vS + r * 132 + c) = (f32x4){a[0], a[1], a[2], a[3]}; *(LAS f32x4*)(vS + r * 132 + c + 4) = (f32x4){a[4], a[5], a[6], a[7]};
        }
    }
    __syncthreads();
    {
        const int half = wave >> 2, ti = (wave >> 1) & 1, tj = wave & 1, r = lane & 31, hh = lane >> 5;
        f32x16 acc;
#pragma unroll
        for (int e = 0; e < 16; ++e) acc[e] = 0.f;
        if (!(ti == 0 && tj == 1)) {
            const int offA = (32 * ti + r) * 272 + 16 * hh, offB = (32 * tj + r) * 272 + 16 * hh;
#pragma unroll
            for (int ks = 0; ks < 8; ++ks) {
                const bf16x8 bh_ = ld_b128(lds + CP_KH + offB + 32 * ks);
                if (half == 0) {
                    const bf16x8 ah = ld_b128(lds + CP_KH + offA + 32 * ks), al = ld_b128(lds + CP_KL + offA + 32 * ks), bl = ld_b128(lds + CP_KL + offB + 32 * ks);
                    acc = __builtin_amdgcn_mfma_f32_32x32x16_bf16(ah, bh_, acc, 0, 0, 0);
                    acc = __builtin_amdgcn_mfma_f32_32x32x16_bf16(ah, bl, acc, 0, 0, 0);
                    acc = __builtin_amdgcn_mfma_f32_32x32x16_bf16(al, bh_, acc, 0, 0, 0);
                } else {
                    acc = __builtin_amdgcn_mfma_f32_32x32x16_bf16(ld_b128(lds + CP_QB + offA + 32 * ks), bh_, acc, 0, 0, 0);
                }
            }
        }
        const int jj = 32 * tj + r; const float gj = gcS[jj];
#pragma unroll
        for (int i = 0; i < 16; ++i) {
            const int ii = 32 * ti + (i & 3) + 8 * (i >> 2) + 4 * hh;
            const float dec = (ii >= jj) ? __expf(gcS[ii] - gj) : 0.f;
            if (half == 0) Ls[ii * 68 + jj] = (ii > jj) ? betaS[ii] * acc[i] * dec : 0.f;
            else { const unsigned w = pk2(acc[i] * dec, 0.f); qk_o[ii * 64 + jj] = (bf16_t)(w & 0xffffu); }
        }
    }
    __syncthreads();
    if (tid < 256) {
        const int c = tid;
        unsigned msb = (c < 128) ? (unsigned)(CP_V + 4 * c) : (unsigned)(CP_K + 4 * (c - 128)), sclb = (c < 128) ? (unsigned)CP_MISC : (unsigned)(CP_MISC + 512), lsb = CP_L;
        asm volatile("" : "+v"(msb), "+v"(sclb), "+v"(lsb));
        const LAS float* Msrc = (const LAS float*)(lds + msb);
        const LAS float* scl = (const LAS float*)(lds + sclb);
        const LAS float* Lsr = (const LAS float*)(lds + lsb);
        float sol[64];
#pragma unroll
        for (int i = 0; i < 64; ++i) {
            float a = Msrc[i * 132] * scl[i];
#pragma unroll
            for (int j4 = 0; j4 < i; j4 += 4) {
                const f32x4 l = *(const LAS f32x4*)(Lsr + i * 68 + j4);
                a -= l[0] * sol[j4];
                if (j4 + 1 < i) a -= l[1] * sol[j4 + 1];
                if (j4 + 2 < i) a -= l[2] * sol[j4 + 2];
                if (j4 + 3 < i) a -= l[3] * sol[j4 + 3];
            }
            sol[i] = a;
            if (c >= 128) { const unsigned w = pk2(-a, 0.f); kcum_o[i * 128 + (c - 128)] = (bf16_t)(w & 0xffffu); }
        }
        if (c < 128) {
#pragma unroll
            for (int q = 0; q < 8; ++q) { u32x4 w; w.x = pk2(sol[8 * q], sol[8 * q + 1]); w.y = pk2(sol[8 * q + 2], sol[8 * q + 3]); w.z = pk2(sol[8 * q + 4], sol[8 * q + 5]); w.w = pk2(sol[8 * q + 6], sol[8 * q + 7]);
                *(u32x4*)(valT_o + c * 64 + 8 * q) = w; }
        }
    } else {
        const int t = tid - 256;
        for (int it = t; it < 1024; it += 256) { const int i = it >> 4, c = (it & 15) * 8; const float e = egS[i];
            const u32x4 q = *(const LAS u32x4*)(lds + CP_QB + i * 272 + c * 2);
            u32x4 w; w.x = pk2(bflo(q.x) * e, bfhi(q.x) * e); w.y = pk2(bflo(q.y) * e, bfhi(q.y) * e); w.z = pk2(bflo(q.z) * e, bfhi(q.z) * e); w.w = pk2(bflo(q.w) * e, bfhi(q.w) * e);
            *(u32x4*)(qg_o + i * 128 + c) = w; }
        for (int it = t; it < 1024; it += 256) { const int d = it & 127, i0 = (it >> 7) * 8; float v[8];
#pragma unroll
            for (int e = 0; e < 8; ++e) v[e] = kS[(i0 + e) * 132 + d] * etS[i0 + e];
            u32x4 w; w.x = pk2(v[0], v[1]); w.y = pk2(v[2], v[3]); w.z = pk2(v[4], v[5]); w.w = pk2(v[6], v[7]);
            *(u32x4*)(ktT_o + d * 64 + i0) = w; }
    }
    __syncthreads();
}
__device__ __forceinline__ void pool_diff(const Params& p) {
    unsigned char* ws = p.ws;
    const bf16_t* proj = (const bf16_t*)(ws + OFF_PROJ); bf16_t* dp = (bf16_t*)(ws + OFF_DPOOL);
    for (int it = blockIdx.x * 512 + threadIdx.x; it < MTOK * 128; it += gridDim.x * 512) {
        const int t = it >> 7, c = (it & 127) * 8, g = c >> 8, w = 2 << g, tl = t & (SEQ - 1);
        const int cnt = (tl + 1 < w) ? tl + 1 : w;
        const bf16_t* src = proj + (size_t)t * NPROJ + 4096 + c;
        u32x4 raw[16];
#pragma unroll
        for (int j = 0; j < 16; ++j) raw[j] = *(const u32x4*)(src - (size_t)((j < cnt) ? j : 0) * NPROJ);
        float s[8];
#pragma unroll
        for (int e = 0; e < 8; ++e) s[e] = 0.f;
#pragma unroll
        for (int j = 15; j >= 1; --j) { const float m = (j < cnt) ? 1.0f : 0.0f;
            s[0] += m * bflo(raw[j].x); s[1] += m * bfhi(raw[j].x); s[2] += m * bflo(raw[j].y); s[3] += m * bfhi(raw[j].y); s[4] += m * bflo(raw[j].z); s[5] += m * bfhi(raw[j].z); s[6] += m * bflo(raw[j].w); s[7] += m * bfhi(raw[j].w); }
        const float u0[8] = {bflo(raw[0].x), bfhi(raw[0].x), bflo(raw[0].y), bfhi(raw[0].y), bflo(raw[0].z), bfhi(raw[0].z), bflo(raw[0].w), bfhi(raw[0].w)};
        const float inv = 1.0f / (float)cnt;
        u32x4 o; o.x = pk2((s[0] + u0[0]) * inv - u0[0], (s[1] + u0[1]) * inv - u0[1]); o.y = pk2((s[2] + u0[2]) * inv - u0[2], (s[3] + u0[3]) * inv - u0[3]);
        o.z = pk2((s[4] + u0[4]) * inv - u0[4], (s[5] + u0[5]) * inv - u0[5]); o.w = pk2((s[6] + u0[6]) * inv - u0[6], (s[7] + u0[7]) * inv - u0[7]);
        *(u32x4*)(dp + (size_t)t * 1024 + c) = o;
    }
}

constexpr int SC_KC = 0, SC_QG = 16896, SC_KT = 33792, SC_QK = 51200, SC_VT = 59904, SC_OT = 77312, SC_ONW = 144896;
__device__ __forceinline__ bf16x8 packh(const f32x16& x, int s) {
    u32x4 r; r.x = pk2(x[8 * s + 0], x[8 * s + 1]); r.y = pk2(x[8 * s + 2], x[8 * s + 3]); r.z = pk2(x[8 * s + 4], x[8 * s + 5]); r.w = pk2(x[8 * s + 6], x[8 * s + 7]);
    return __builtin_bit_cast(bf16x8, r);
}
__device__ __forceinline__ bf16x8 frag_rd(const LAS unsigned char* base, int byteoff) {
    const u32x2 lo = *(const LAS u32x2*)(base + byteoff), hi = *(const LAS u32x2*)(base + byteoff + 16);
    u32x4 r; r.x = lo.x; r.y = lo.y; r.z = hi.x; r.w = hi.y; return __builtin_bit_cast(bf16x8, r);
}
#define SC_BAR() do { asm volatile("s_waitcnt lgkmcnt(0)" ::: "memory"); __builtin_amdgcn_s_barrier(); asm volatile("" ::: "memory"); } while (0)
__device__ __forceinline__ void scan_compute(const Params& p, LAS unsigned char* lds, int bh, int wave, int lane) {
    unsigned char* ws = p.ws;
    const int r = lane & 31, hh = lane >> 5;
    const unsigned char* cb0 = ws + OFF_CHUNK + (size_t)(bh * 32) * CHUNK_BYTES;
    float glv = ((const float*)(ws + OFF_GLAST))[bh * 32 + (lane & 31)];
    f32x16 S[4]; bf16x8 Sb[8]; f32x16 vn[2];
#pragma unroll
    for (int i = 0; i < 4; ++i)
#pragma unroll
        for (int e = 0; e < 16; ++e) S[i][e] = 0.f;
#pragma unroll
    for (int i = 0; i < 8; ++i) Sb[i] = (bf16x8){0, 0, 0, 0, 0, 0, 0, 0};
    asm volatile("s_waitcnt vmcnt(0)" : "+v"(glv));
    SC_BAR();
    const int vto = (32 * wave + r) * 136 + 8 * hh;
    const int fo132 = r * 264 + 8 * hh, fo68 = r * 136 + 8 * hh;
#define FRQ(base, mi, ks) frag_rd(lds + (base), fo132 + (mi) * (32 * 264) + (ks) * 32)
#define FRK(base, mi, ks) frag_rd(lds + (base), fo68 + (mi) * (32 * 136) + (ks) * 32)
#define MF(a, b_, c) c = __builtin_amdgcn_mfma_f32_32x32x16_bf16(a, b_, c, 0, 0, 0)
#define SB0 __builtin_amdgcn_sched_barrier(0)
    for (int n = 0; n < NCH; ++n) {
        LAS float* oT = (LAS float*)(lds + SC_OT + (n & 1) * 33792);
        const float gl = __builtin_bit_cast(float, __builtin_amdgcn_readlane(__builtin_bit_cast(int, glv), n));
        f32x16 o[2];
#pragma unroll
        for (int mi = 0; mi < 2; ++mi)
#pragma unroll
            for (int e = 0; e < 16; ++e) o[mi][e] = 0.f;
        bf16x8 f0[4], f1[4];
#pragma unroll
        for (int mi = 0; mi < 2; ++mi)
#pragma unroll
            for (int g4 = 0; g4 < 4; ++g4) { const u32x2 w = *(const LAS u32x2*)(lds + SC_VT + vto + (32 * mi + 8 * g4) * 2);
                vn[mi][4 * g4 + 0] = bflo(w.x); vn[mi][4 * g4 + 1] = bfhi(w.x); vn[mi][4 * g4 + 2] = bflo(w.y); vn[mi][4 * g4 + 3] = bfhi(w.y); }
        f0[0] = FRQ(SC_QG, 0, 0); f0[1] = FRQ(SC_QG, 1, 0); f0[2] = FRQ(SC_QG, 0, 1); f0[3] = FRQ(SC_QG, 1, 1); SB0;
        f1[0] = FRQ(SC_QG, 0, 2); f1[1] = FRQ(SC_QG, 1, 2); f1[2] = FRQ(SC_QG, 0, 3); f1[3] = FRQ(SC_QG, 1, 3); SB0;
        MF(f0[0], Sb[0], o[0]); MF(f0[1], Sb[0], o[1]); MF(f0[2], Sb[1], o[0]); MF(f0[3], Sb[1], o[1]); S[0] = S[0] * gl; SB0;
        f0[0] = FRQ(SC_QG, 0, 4); f0[1] = FRQ(SC_QG, 1, 4); f0[2] = FRQ(SC_QG, 0, 5); f0[3] = FRQ(SC_QG, 1, 5); SB0;
        MF(f1[0], Sb[2], o[0]); MF(f1[1], Sb[2], o[1]); MF(f1[2], Sb[3], o[0]); MF(f1[3], Sb[3], o[1]); S[1] = S[1] * gl; SB0;
        f1[0] = FRQ(SC_QG, 0, 6); f1[1] = FRQ(SC_QG, 1, 6); f1[2] = FRQ(SC_QG, 0, 7); f1[3] = FRQ(SC_QG, 1, 7); SB0;
        MF(f0[0], Sb[4], o[0]); MF(f0[1], Sb[4], o[1]); MF(f0[2], Sb[5], o[0]); MF(f0[3], Sb[5], o[1]); S[2] = S[2] * gl; SB0;
        f0[0] = FRQ(SC_KC, 0, 0); f0[1] = FRQ(SC_KC, 1, 0); f0[2] = FRQ(SC_KC, 0, 1); f0[3] = FRQ(SC_KC, 1, 1); SB0;
        MF(f1[0], Sb[6], o[0]); MF(f1[1], Sb[6], o[1]); MF(f1[2], Sb[7], o[0]); MF(f1[3], Sb[7], o[1]); S[3] = S[3] * gl; SB0;
        f1[0] = FRQ(SC_KC, 0, 2); f1[1] = FRQ(SC_KC, 1, 2); f1[2] = FRQ(SC_KC, 0, 3); f1[3] = FRQ(SC_KC, 1, 3); SB0;
        MF(f0[0], Sb[0], vn[0]); MF(f0[1], Sb[0], vn[1]); MF(f0[2], Sb[1], vn[0]); MF(f0[3], Sb[1], vn[1]); SB0;
        f0[0] = FRQ(SC_KC, 0, 4); f0[1] = FRQ(SC_KC, 1, 4); f0[2] = FRQ(SC_KC, 0, 5); f0[3] = FRQ(SC_KC, 1, 5); SB0;
        MF(f1[0], Sb[2], vn[0]); MF(f1[1], Sb[2], vn[1]); MF(f1[2], Sb[3], vn[0]); MF(f1[3], Sb[3], vn[1]); SB0;
        f1[0] = FRQ(SC_KC, 0, 6); f1[1] = FRQ(SC_KC, 1, 6); f1[2] = FRQ(SC_KC, 0, 7); f1[3] = FRQ(SC_KC, 1, 7); SB0;
        MF(f0[0], Sb[4], vn[0]); MF(f0[1], Sb[4], vn[1]); MF(f0[2], Sb[5], vn[0]); MF(f0[3], Sb[5], vn[1]); SB0;
        f0[0] = FRK(SC_QK, 0, 0); f0[1] = FRK(SC_QK, 1, 0); f0[2] = FRK(SC_QK, 0, 1); f0[3] = FRK(SC_QK, 1, 1); SB0;
        MF(f1[0], Sb[6], vn[0]); MF(f1[1], Sb[6], vn[1]); MF(f1[2], Sb[7], vn[0]); MF(f1[3], Sb[7], vn[1]); SB0;
        f1[0] = FRK(SC_QK, 0, 2); f1[1] = FRK(SC_QK, 1, 2); f1[2] = FRK(SC_QK, 0, 3); f1[3] = FRK(SC_QK, 1, 3); SB0;
        bf16x8 vb[4];
#pragma unroll
        for (int ks = 0; ks < 4; ++ks) vb[ks] = packh(vn[ks >> 1], ks & 1);
        SB0;
        MF(f0[0], vb[0], o[0]); MF(f0[1], vb[0], o[1]); MF(f0[2], vb[1], o[0]); MF(f0[3], vb[1], o[1]); SB0;
        f0[0] = FRK(SC_KT, 0, 0); f0[1] = FRK(SC_KT, 1, 0); f0[2] = FRK(SC_KT, 2, 0); f0[3] = FRK(SC_KT, 3, 0); SB0;
        MF(f1[0], vb[2], o[0]); MF(f1[1], vb[2], o[1]); MF(f1[2], vb[3], o[0]); MF(f1[3], vb[3], o[1]); SB0;
        f1[0] = FRK(SC_KT, 0, 1); f1[1] = FRK(SC_KT, 1, 1); f1[2] = FRK(SC_KT, 2, 1); f1[3] = FRK(SC_KT, 3, 1); SB0;
        MF(f0[0], vb[0], S[0]); MF(f0[1], vb[0], S[1]); MF(f0[2], vb[0], S[2]); MF(f0[3], vb[0], S[3]); SB0;
        f0[0] = FRK(SC_KT, 0, 2); f0[1] = FRK(SC_KT, 1, 2); f0[2] = FRK(SC_KT, 2, 2); f0[3] = FRK(SC_KT, 3, 2);
#pragma unroll
        for (int mi = 0; mi < 2; ++mi)
#pragma unroll
            for (int i = 0; i < 16; ++i) oT[(32 * mi + (i & 3) + 8 * (i >> 2) + 4 * hh) * 132 + 32 * wave + r] = o[mi][i];
        SB0;
        MF(f1[0], vb[1], S[0]); MF(f1[1], vb[1], S[1]); MF(f1[2], vb[1], S[2]); MF(f1[3], vb[1], S[3]); SB0;
        f1[0] = FRK(SC_KT, 0, 3); f1[1] = FRK(SC_KT, 1, 3); f1[2] = FRK(SC_KT, 2, 3); f1[3] = FRK(SC_KT, 3, 3); SB0;
        MF(f0[0], vb[2], S[0]); MF(f0[1], vb[2], S[1]); MF(f0[2], vb[2], S[2]); MF(f0[3], vb[2], S[3]); SB0;
        MF(f1[0], vb[3], S[0]); MF(f1[1], vb[3], S[1]); MF(f1[2], vb[3], S[2]); MF(f1[3], vb[3], S[3]); SB0;
#pragma unroll
        for (int mt = 0; mt < 4; ++mt) { Sb[2 * mt] = packh(S[mt], 0); Sb[2 * mt + 1] = packh(S[mt], 1); }
        SC_BAR();
        SC_BAR();
    }
#undef FRQ
#undef FRK
#undef MF
#undef SB0
}
__device__ __forceinline__ void scan_finalize(const LAS float* oP, const u32x4 (&zr)[4], const LAS float* onw, bf16_t* mp) {
    f32x4 v[8]; float ss = 0.f;
#pragma unroll
    for (int e = 0; e < 8; ++e) { v[e] = *(const LAS f32x4*)(oP + 4 * e); ss += (v[e][0] * v[e][0] + v[e][1] * v[e][1]) + (v[e][2] * v[e][2] + v[e][3] * v[e][3]); }
    ss += __shfl_xor(ss, 1); ss += __shfl_xor(ss, 2);
    const float rs = rsqrtf(ss * (1.0f / HD) + EPS);
#pragma unroll
    for (int q = 0; q < 4; ++q) {
        const f32x4 a = v[2 * q] * rs, c2 = v[2 * q + 1] * rs; const u32x4 z = zr[q];
        u32x4 w;
        w.x = pk2(a[0] * onw[8 * q + 0] * silu_f(bflo(z.x)), a[1] * onw[8 * q + 1] * silu_f(bfhi(z.x)));
        w.y = pk2(a[2] * onw[8 * q + 2] * silu_f(bflo(z.y)), a[3] * onw[8 * q + 3] * silu_f(bfhi(z.y)));
        w.z = pk2(c2[0] * onw[8 * q + 4] * silu_f(bflo(z.z)), c2[1] * onw[8 * q + 5] * silu_f(bfhi(z.z)));
        w.w = pk2(c2[2] * onw[8 * q + 6] * silu_f(bflo(z.w)), c2[3] * onw[8 * q + 7] * silu_f(bfhi(z.w)));
        *(u32x4*)(mp + 8 * q) = w;
    }
}
__device__ __forceinline__ void scan_loader(const Params& p, LAS unsigned char* lds, int bh, int lt) {
    unsigned char* ws = p.ws;
    const int b = bh >> 3, h = bh & 7;
    const bf16_t* proj = (const bf16_t*)(ws + OFF_PROJ); bf16_t* mix = (bf16_t*)(ws + OFF_MIX);
    const unsigned char* src0 = ws + OFF_CHUNK + (size_t)(bh * 32) * CHUNK_BYTES + lt * 16;
    const int frow = lt >> 2, fpart = lt & 3;
    const int b132 = (lt >> 4) * 264 + (lt & 15) * 16, b68 = (lt >> 3) * 136 + (lt & 7) * 16, bvt = SC_VT + b68;
    if (lt < 32) *(LAS f32x4*)(lds + SC_ONW + lt * 16) = *(const f32x4*)(p.in[I_ONW] + 4 * lt);
    u32x4 sA[18], sB[18];
#define SC_LOAD(dst, nn) do { const unsigned char* _s = src0 + (size_t)((nn) < NCH ? (nn) : NCH - 1) * CHUNK_BYTES; _Pragma("unroll") for (int i = 0; i < 18; ++i) dst[i] = *(const u32x4*)(_s + i * 4096); } while (0)
#define SC_DST(i) ((i) < 4 ? bvt + ((i) & 3) * 4352 : (i) < 8 ? SC_KC + b132 + ((i) & 3) * 4224 : (i) < 12 ? SC_QG + b132 + ((i) & 3) * 4224 : (i) < 16 ? SC_KT + b68 + ((i) & 3) * 4352 : SC_QK + b68 + ((i) & 3) * 4352)
#define SC_STORE(srcv) do { _Pragma("unroll") for (int i = 0; i < 18; ++i) { *(LAS u32x2*)(lds + SC_DST(i)) = (u32x2){srcv[i].x, srcv[i].y}; *(LAS u32x2*)(lds + SC_DST(i) + 8) = (u32x2){srcv[i].z, srcv[i].w}; } } while (0)
    const LAS float* onwp = (const LAS float*)(lds + SC_ONW) + 32 * fpart;
    SC_LOAD(sA, 0); SC_LOAD(sB, 1);
    SC_STORE(sA);
    SC_BAR();
    const bf16_t* zbase = proj + (size_t)(b * SEQ + frow) * NPROJ + 3072 + h * HD + 32 * fpart;
    bf16_t* mbase = mix + (size_t)(b * SEQ + frow) * DM + h * HD + 32 * fpart;
    u32x4 zr[4];
#pragma unroll
    for (int q = 0; q < 4; ++q) zr[q] = *(const u32x4*)(zbase + 8 * q);
    for (int n = 0; n < NCH; n += 2) {
        SC_LOAD(sA, n + 2);
        if (n >= 1) scan_finalize((const LAS float*)(lds + SC_OT + ((n - 1) & 1) * 33792) + frow * 132 + 32 * fpart, zr, onwp, mbase + (size_t)(n - 1) * CH * DM);
#pragma unroll
        for (int q = 0; q < 4; ++q) zr[q] = *(const u32x4*)(zbase + (size_t)n * CH * NPROJ + 8 * q);
        SC_BAR();
        SC_STORE(sB);
        SC_BAR();
        SC_LOAD(sB, n + 3);
        scan_finalize((const LAS float*)(lds + SC_OT + (n & 1) * 33792) + frow * 132 + 32 * fpart, zr, onwp, mbase + (size_t)n * CH * DM);
#pragma unroll
        for (int q = 0; q < 4; ++q) zr[q] = *(const u32x4*)(zbase + (size_t)(n + 1) * CH * NPROJ + 8 * q);
        SC_BAR();
        SC_STORE(sA);
        SC_BAR();
    }
    scan_finalize((const LAS float*)(lds + SC_OT + ((NCH - 1) & 1) * 33792) + frow * 132 + 32 * fpart, zr, onwp, mbase + (size_t)(NCH - 1) * CH * DM);
#undef SC_LOAD
#undef SC_STORE
#undef SC_DST
}
__device__ __forceinline__ void scan_phase(const Params& p, LAS unsigned char* lds, int bh) {
    const int tid = threadIdx.x, wave = __builtin_amdgcn_readfirstlane(tid >> 6);
    if (wave < 4) scan_compute(p, lds, bh, wave, tid & 63);
    else scan_loader(p, lds, bh, tid & 255);
    __syncthreads();
}

__device__ __forceinline__ void act_phase(const Params& p) {
    unsigned char* ws = p.ws;
    const bf16_t* up = (const bf16_t*)(ws + OFF_UP); bf16_t* act = (bf16_t*)(ws + OFF_ACT);
    const float* cw = p.in[I_CONVF]; const float* cbias = p.in[I_CONVFB];
    constexpr int NCG = DFF / 8, RB = 16;
    for (int it = blockIdx.x * 512 + threadIdx.x; it < (MTOK / RB) * NCG; it += gridDim.x * 512) {
        const int cgp = it % NCG, rb = it / NCG, c = cgp * 8, t0 = rb * RB;
        float wg[3][8], wv[3][8], bg[8], bv[8];
#pragma unroll
        for (int j = 0; j < 3; ++j)
#pragma unroll
            for (int e = 0; e < 8; ++e) { wg[j][e] = cw[j * NUP + c + e]; wv[j][e] = cw[j * NUP + DFF + c + e]; }
#pragma unroll
        for (int e = 0; e < 8; ++e) { bg[e] = cbias[c + e]; bv[e] = cbias[DFF + c + e]; }
        float g2[8], g1[8], v2[8], v1[8];
        const bool first = ((t0 & (SEQ - 1)) == 0);
#pragma unroll
        for (int e = 0; e < 8; ++e) { g2[e] = 0.f; g1[e] = 0.f; v2[e] = 0.f; v1[e] = 0.f; }
        if (!first) {
            const u32x4 a = *(const u32x4*)(up + (size_t)(t0 - 2) * NUP + c), b2 = *(const u32x4*)(up + (size_t)(t0 - 1) * NUP + c);
            const u32x4 cc = *(const u32x4*)(up + (size_t)(t0 - 2) * NUP + DFF + c), d = *(const u32x4*)(up + (size_t)(t0 - 1) * NUP + DFF + c);
            g2[0] = bflo(a.x); g2[1] = bfhi(a.x); g2[2] = bflo(a.y); g2[3] = bfhi(a.y); g2[4] = bflo(a.z); g2[5] = bfhi(a.z); g2[6] = bflo(a.w); g2[7] = bfhi(a.w);
            g1[0] = bflo(b2.x); g1[1] = bfhi(b2.x); g1[2] = bflo(b2.y); g1[3] = bfhi(b2.y); g1[4] = bflo(b2.z); g1[5] = bfhi(b2.z); g1[6] = bflo(b2.w); g1[7] = bfhi(b2.w);
            v2[0] = bflo(cc.x); v2[1] = bfhi(cc.x); v2[2] = bflo(cc.y); v2[3] = bfhi(cc.y); v2[4] = bflo(cc.z); v2[5] = bfhi(cc.z); v2[6] = bflo(cc.w); v2[7] = bfhi(cc.w);
            v1[0] = bflo(d.x); v1[1] = bfhi(d.x); v1[2] = bflo(d.y); v1[3] = bfhi(d.y); v1[4] = bflo(d.z); v1[5] = bfhi(d.z); v1[6] = bflo(d.w); v1[7] = bfhi(d.w);
        }
#pragma unroll 4
        for (int rr = 0; rr < RB; ++rr) {
            const int t = t0 + rr;
            const u32x4 a = *(const u32x4*)(up + (size_t)t * NUP + c), d = *(const u32x4*)(up + (size_t)t * NUP + DFF + c);
            float g0[8] = {bflo(a.x), bfhi(a.x), bflo(a.y), bfhi(a.y), bflo(a.z), bfhi(a.z), bflo(a.w), bfhi(a.w)};
            float v0[8] = {bflo(d.x), bfhi(d.x), bflo(d.y), bfhi(d.y), bflo(d.z), bfhi(d.z), bflo(d.w), bfhi(d.w)};
            float o[8];
#pragma unroll
            for (int e = 0; e < 8; ++e) {
                const float G = wg[0][e] * g2[e] + wg[1][e] * g1[e] + wg[2][e] * g0[e] + bg[e];
                const float V = wv[0][e] * v2[e] + wv[1][e] * v1[e] + wv[2][e] * v0[e] + bv[e];
                o[e] = silu_f(G) * V; g2[e] = g1[e]; g1[e] = g0[e]; v2[e] = v1[e]; v1[e] = v0[e];
            }
            u32x4 w; w.x = pk2(o[0], o[1]); w.y = pk2(o[2], o[3]); w.z = pk2(o[4], o[5]); w.w = pk2(o[6], o[7]);
            *(u32x4*)(act + (size_t)t * DFF + c) = w;
        }
    }
}
__device__ __forceinline__ void final_phase(const Params& p) {
    const float* ssq3 = (const float*)(p.ws + OFF_SSQ3); const float* fw = p.in[I_FNW];
    f32x4* o = (f32x4*)p.out;
    for (int i = blockIdx.x * 512 + threadIdx.x; i < MTOK * DM / 4; i += gridDim.x * 512) {
        const int row = i >> 9, c4 = i & 511;
        const float rs = rsqrtf(ssq3[row] * (1.0f / DM) + EPS);
        const f32x4 w = *(const f32x4*)(fw + 4 * c4);
        o[i] = o[i] * rs * w;
    }
}

constexpr int NPHASE = 9;
template <bool COOP>
__global__ void __launch_bounds__(512, 2) mk_fwd(Params p) {
    extern __shared__ __attribute__((aligned(16))) unsigned char lds_raw[];
    LAS unsigned char* lds = (LAS unsigned char*)lds_raw;
    unsigned char* ws = p.ws;
    const int lo = p.ph_lo, hi = p.ph_hi;
    const int G = gridDim.x, bid = blockIdx.x;
#define IN(k) (lo <= (k) && (k) < hi)
#define SEAM(k) do { if (COOP) { if ((k) + 1 < hi) xcd_barrier(bar); } } while (0)
    XcdBarrier bar; bar.bar = (unsigned*)(ws + OFF_BAR); bar.x = 0; bar.st = (volatile LAS unsigned*)(lds + LDS_MISC);
    if (COOP) {
        if (hi > 1000) cg::this_grid().sync();
        if (threadIdx.x < 4) ((LAS unsigned*)(lds + LDS_MISC))[threadIdx.x] = 0u;
        __syncthreads();
        bar = xcd_barrier_post((unsigned*)(ws + OFF_BAR), (volatile LAS unsigned*)(lds + LDS_MISC));
    }
    if (IN(0)) { phase_prep(p, lds); SEAM(0); }
    if (IN(1)) {
        pg8::Gemm g{(const bf16_t*)(ws + OFF_XB), (const bf16_t*)(ws + OFF_WIN), MTOK, N1, DM, DM, DM, 0};
        pg8::StaticOrder S; S.init(MTOK, N1, G, bid);
        EpiProj E{(bf16_t*)(ws + OFF_PROJ), (float*)(ws + OFF_LOGIT), (const float*)(ws + OFF_RSTD1)};
        pg8::gemm_phase<EpiProj>(lds, g, S, E);
        SEAM(1);
    }
    if (IN(2)) {
        for (int item = bid; item < 1024; item += G) chunk_prep(p, lds, item);
        pool_diff(p);
        SEAM(2);
    }
    if (IN(3)) {
        if (bid < 32) scan_phase(p, lds, bid);
        else {
            pg8::Gemm g{(const bf16_t*)(ws + OFF_DPOOL), (const bf16_t*)(ws + OFF_POOLT), MTOK, 1024, 256, 1024, 256, 512};
            pg8::StaticOrder S; S.init(MTOK, 1024, G - 32, bid - 32);
            EpiBf E{(bf16_t*)(ws + OFF_MIX), DM, 1024, nullptr};
            pg8::gemm_phase<EpiBf>(lds, g, S, E);
            phase_prep2(p, lds, (bid - 32) * 8 + (int)(threadIdx.x >> 6), (G - 32) * 8);
        }
        SEAM(3);
    }
    if (IN(4)) {
        pg8::Gemm g{(const bf16_t*)(ws + OFF_MIX), (const bf16_t*)(ws + OFF_WOUT), MTOK, DM, DM, DM, DM, 0};
        pg8::StaticOrder S; S.init(MTOK, DM, G, bid);
        EpiRes E{p.in[I_X], p.out, (bf16_t*)(ws + OFF_XB), (float*)(ws + OFF_SSQ2)};
        pg8::gemm_phase<EpiRes>(lds, g, S, E);
        SEAM(4);
    }
    if (IN(5)) {
        pg8::Gemm g{(const bf16_t*)(ws + OFF_XB), (const bf16_t*)(ws + OFF_WUP), MTOK, NUP, DM, DM, DM, 0};
        pg8::StaticOrder S; S.init(MTOK, NUP, G, bid);
        EpiBf E{(bf16_t*)(ws + OFF_UP), NUP, 0, (const float*)(ws + OFF_SSQ2)};
        pg8::gemm_phase<EpiBf>(lds, g, S, E);
        SEAM(5);
    }
    if (IN(6)) { act_phase(p); SEAM(6); }
    if (IN(7)) {
        pg8::Gemm g{(const bf16_t*)(ws + OFF_ACT), (const bf16_t*)(ws + OFF_WDOWN), MTOK, DM, DFF, DFF, DFF, 0};
        pg8::StaticOrder S; S.init(MTOK, DM, G, bid);
        EpiRes E{p.out, p.out, nullptr, (float*)(ws + OFF_SSQ3)};
        pg8::gemm_phase<EpiRes>(lds, g, S, E);
        SEAM(7);
    }
    if (IN(8)) { final_phase(p); }
#undef IN
#undef SEAM
}

extern "C" void kernel_launch(void* const* d_in, const int* in_sizes, int n_in, void* d_out, int out_size, void* d_ws, size_t ws_size, hipStream_t stream) {
    static int grid = 0;
    if (!grid) {
        if (n_in != 16 || out_size != MTOK * DM || ws_size < WS_END) { fprintf(stderr, "kernel_launch: unexpected shapes (n_in %d out %d ws %zu, need %zu)\n", n_in, out_size, ws_size, (size_t)WS_END); grid = -1; return; }
        int dev = 0, cus = 0, per_cu = 0;
        hipGetDevice(&dev); hipDeviceGetAttribute(&cus, hipDeviceAttributeMultiprocessorCount, dev);
#if ONE_LAUNCH
        hipFuncSetAttribute((const void*)mk_fwd<true>, hipFuncAttributeMaxDynamicSharedMemorySize, LDS_BYTES);
        hipOccupancyMaxActiveBlocksPerMultiprocessor(&per_cu, mk_fwd<true>, 512, LDS_BYTES);
#else
        hipFuncSetAttribute((const void*)mk_fwd<false>, hipFuncAttributeMaxDynamicSharedMemorySize, LDS_BYTES);
        hipOccupancyMaxActiveBlocksPerMultiprocessor(&per_cu, mk_fwd<false>, 512, LDS_BYTES);
#endif
        if (per_cu < 1) per_cu = 1;
        grid = cus * per_cu;
        if (grid < 64) { fprintf(stderr, "kernel_launch: grid %d too small\n", grid); grid = -1; return; }
    }
    if (grid < 0) return;
    Params p{};
    for (int i = 0; i < 16; ++i) p.in[i] = (const float*)d_in[i];
    p.out = (float*)d_out; p.ws = (unsigned char*)d_ws;
#if ONE_LAUNCH
    p.ph_lo = 0; p.ph_hi = NPHASE;
    void* args[] = {&p};
    if (hipMemsetAsync((unsigned char*)d_ws + OFF_BAR, 0, XCD_BAR_WORDS * 4, stream) != hipSuccess) { fprintf(stderr, "kernel_launch: memset failed\n"); return; }
    hipError_t e = hipLaunchCooperativeKernel((const void*)mk_fwd<true>, dim3(grid), dim3(512), args, LDS_BYTES, stream);
    if (e != hipSuccess) fprintf(stderr, "cooperative launch failed: %s (grid %d)\n", hipGetErrorString(e), grid);
#else
    static const int plist[] = {PLIST};
    for (int ph : plist) { p.ph_lo = ph; p.ph_hi = ph + 1; hipLaunchKernelGGL(mk_fwd<false>, dim3(grid), dim3(512), LDS_BYTES, stream, p); }
#endif
}
```
